# Optimizing an MI355X kernel written in HIP

```python
import jax, jax.numpy as jnp
from jax import lax
import numpy as np

D_MODEL = 1024
BATCH = 16
SEQ = 2048
DEPTH = 1

D_MIX = D_MODEL
D_RG = D_MIX // 2
D_SC = D_MIX - D_RG
RG_HEADS = 8
RG_HEAD_DIM = D_RG // RG_HEADS
RG_CONV = 4
RG_C = 8.0
SC_GROUPS = 8
SC_CONV = 3
D_IN_PROJ = 2 * D_RG + 3 * D_SC
N_GROUPS = 4
EXPERTS_PER_GROUP = 8
N_EXPERTS = N_GROUPS * EXPERTS_PER_GROUP
TOP_K = 2
D_EXPERT = D_MODEL // 4
LN_EPS = 1e-5
DEEPNORM_ALPHA = (2 * DEPTH) ** 0.25
DEEPNORM_BETA = (8 * DEPTH) ** -0.25

kernel_name = "hymba_rglru_shortconv_hmoe_deepnorm"


def layer_norm(x, g, b):
    xf = x.astype(jnp.float32)
    mu = jnp.mean(xf, axis=-1, keepdims=True)
    var = jnp.mean(jnp.square(xf - mu), axis=-1, keepdims=True)
    y = (xf - mu) * lax.rsqrt(var + LN_EPS) * g.astype(jnp.float32) + b.astype(jnp.float32)
    return y.astype(x.dtype)


def causal_depthwise_conv(x, w):
    k, c = w.shape
    rhs = w.astype(x.dtype)[:, None, :]
    return lax.conv_general_dilated(
        x, rhs, window_strides=(1,), padding=[(k - 1, 0)],
        dimension_numbers=("NWC", "WIO", "NWC"), feature_group_count=c)


def _linear_recurrence_combine(e1, e2):
    a1, b1 = e1
    a2, b2 = e2
    return (a1 * a2, a2 * b1 + b2)


def rg_lru(xc, gate_a_w, gate_a_b, gate_x_w, gate_x_b, lam):
    bsz, s, _ = xc.shape
    xh = xc.reshape(bsz, s, RG_HEADS, RG_HEAD_DIM)
    r = jax.nn.sigmoid(jnp.einsum("bshi,hij->bshj", xh, gate_a_w).reshape(bsz, s, D_RG) + gate_a_b)
    i = jax.nn.sigmoid(jnp.einsum("bshi,hij->bshj", xh, gate_x_w).reshape(bsz, s, D_RG) + gate_x_b)
    r = r.astype(jnp.float32)
    i = i.astype(jnp.float32)
    log_a = -RG_C * r * jax.nn.softplus(-lam.astype(jnp.float32))
    a = jnp.exp(log_a)
    mult = jnp.sqrt(-jnp.expm1(2.0 * log_a))
    u = mult * (i * xc.astype(jnp.float32))
    _, h = lax.associative_scan(_linear_recurrence_combine, (a, u), axis=1)
    return h.astype(xc.dtype)


def hybrid_token_mixer(x, w_in, rg_conv_w, rg_conv_b, rg_gate_a_w, rg_gate_a_b,
                       rg_gate_x_w, rg_gate_x_b, rg_lambda, sc_conv_w, w_out):
    proj = jnp.einsum("bsd,de->bse", x, w_in)
    splits = [D_RG, 2 * D_RG, 2 * D_RG + D_SC, 2 * D_RG + 2 * D_SC]
    rg_x, rg_gate, sc_b, sc_c, sc_v = jnp.split(proj, splits, axis=-1)
    xc = causal_depthwise_conv(rg_x, rg_conv_w) + rg_conv_b
    h = rg_lru(xc, rg_gate_a_w, rg_gate_a_b, rg_gate_x_w, rg_gate_x_b, rg_lambda)
    y_rg = h * jax.nn.gelu(rg_gate)
    y_sc = sc_b * causal_depthwise_conv(sc_c * sc_v, sc_conv_w)
    y = jnp.concatenate([y_rg, y_sc], axis=-1)
    return jnp.einsum("bse,ed->bsd", y, w_out)


def hierarchical_moe(x, router_group_w, router_group_b, router_expert_w, router_expert_b,
                     exp_w_gate, exp_w_up, exp_w_down):
    bsz, s, d = x.shape
    t = x.reshape(bsz * s, d)
    g_logits = (t @ router_group_w + router_group_b).astype(jnp.float32)
    g_prob = jax.nn.softmax(g_logits, axis=-1)
    g_top_p, g_idx = lax.top_k(g_prob, 1)
    e_logits = (t @ router_expert_w + router_expert_b).astype(jnp.float32)
    e_logits = e_logits.reshape(-1, N_GROUPS, EXPERTS_PER_GROUP)
    e_sel = jnp.take_along_axis(e_logits, g_idx[:, :, None], axis=1)[:, 0]
    e_top_v, e_top_i = lax.top_k(e_sel, TOP_K)
    weights = jax.nn.softmax(e_top_v, axis=-1) * g_top_p
    global_idx = g_idx * EXPERTS_PER_GROUP + e_top_i
    combine = jnp.sum(jax.nn.one_hot(global_idx, N_EXPERTS, dtype=jnp.float32) * weights[..., None], axis=1)
    combine = combine.astype(x.dtype)
    hg = jnp.einsum("td,edf->tef", t, exp_w_gate)
    hu = jnp.einsum("td,edf->tef", t, exp_w_up)
    hid = jax.nn.silu(hg) * hu * combine[:, :, None]
    out = jnp.einsum("tef,efd->td", hid, exp_w_down)
    return out.reshape(bsz, s, d)


def setup_inputs(seed: int = 0) -> dict:
    key = jax.random.key(seed)
    ks = jax.random.split(key, 24)
    f32 = jnp.float32
    nrm = lambda k, shape, scale: jax.random.normal(k, shape, f32) * scale
    x = jax.random.normal(ks[0], (BATCH, SEQ, D_MODEL), f32)
    w_in = nrm(ks[1], (D_MODEL, D_IN_PROJ), D_MODEL ** -0.5)
    rg_conv_w = nrm(ks[2], (RG_CONV, D_RG), RG_CONV ** -0.5)
    rg_conv_b = nrm(ks[3], (D_RG,), 0.02)
    rg_gate_a_w = nrm(ks[4], (RG_HEADS, RG_HEAD_DIM, RG_HEAD_DIM), RG_HEAD_DIM ** -0.5)
    rg_gate_a_b = nrm(ks[5], (D_RG,), 0.02)
    rg_gate_x_w = nrm(ks[6], (RG_HEADS, RG_HEAD_DIM, RG_HEAD_DIM), RG_HEAD_DIM ** -0.5)
    rg_gate_x_b = nrm(ks[7], (D_RG,), 0.02)
    u = jax.random.uniform(ks[8], (D_RG,), f32, 0.9, 0.999)
    sq = u ** (1.0 / RG_C)
    rg_lambda = jnp.log(sq) - jnp.log1p(-sq)
    sc_conv_w = nrm(ks[9], (SC_CONV, D_SC), SC_CONV ** -0.5)
    w_out = nrm(ks[10], (D_MIX, D_MODEL), D_MIX ** -0.5) * DEEPNORM_BETA
    ln1_g = 1.0 + nrm(ks[11], (D_MODEL,), 0.02)
    ln1_b = nrm(ks[12], (D_MODEL,), 0.02)
    router_group_w = nrm(ks[13], (D_MODEL, N_GROUPS), D_MODEL ** -0.5)
    router_group_b = nrm(ks[14], (N_GROUPS,), 0.01)
    router_expert_w = nrm(ks[15], (D_MODEL, N_EXPERTS), D_MODEL ** -0.5)
    router_expert_b = nrm(ks[16], (N_EXPERTS,), 0.01)
    exp_w_gate = nrm(ks[17], (N_EXPERTS, D_MODEL, D_EXPERT), D_MODEL ** -0.5)
    exp_w_up = nrm(ks[18], (N_EXPERTS, D_MODEL, D_EXPERT), D_MODEL ** -0.5)
    exp_w_down = nrm(ks[19], (N_EXPERTS, D_EXPERT, D_MODEL), D_EXPERT ** -0.5) * DEEPNORM_BETA
    ln2_g = 1.0 + nrm(ks[20], (D_MODEL,), 0.02)
    ln2_b = nrm(ks[21], (D_MODEL,), 0.02)
    return {"x": x, "w_in": w_in, "rg_conv_w": rg_conv_w, "rg_conv_b": rg_conv_b,
            "rg_gate_a_w": rg_gate_a_w, "rg_gate_a_b": rg_gate_a_b,
            "rg_gate_x_w": rg_gate_x_w, "rg_gate_x_b": rg_gate_x_b,
            "rg_lambda": rg_lambda, "sc_conv_w": sc_conv_w, "w_out": w_out,
            "ln1_g": ln1_g, "ln1_b": ln1_b,
            "router_group_w": router_group_w, "router_group_b": router_group_b,
            "router_expert_w": router_expert_w, "router_expert_b": router_expert_b,
            "exp_w_gate": exp_w_gate, "exp_w_up": exp_w_up, "exp_w_down": exp_w_down,
            "ln2_g": ln2_g, "ln2_b": ln2_b}


def reference(x, w_in, rg_conv_w, rg_conv_b, rg_gate_a_w, rg_gate_a_b, rg_gate_x_w,
              rg_gate_x_b, rg_lambda, sc_conv_w, w_out, ln1_g, ln1_b,
              router_group_w, router_group_b, router_expert_w, router_expert_b,
              exp_w_gate, exp_w_up, exp_w_down, ln2_g, ln2_b):
    h = x
    for _ in range(DEPTH):
        mix = hybrid_token_mixer(h, w_in, rg_conv_w, rg_conv_b, rg_gate_a_w, rg_gate_a_b,
                                 rg_gate_x_w, rg_gate_x_b, rg_lambda, sc_conv_w, w_out)
        h = layer_norm(DEEPNORM_ALPHA * h + mix, ln1_g, ln1_b)
        ffn = hierarchical_moe(h, router_group_w, router_group_b, router_expert_w,
                               router_expert_b, exp_w_gate, exp_w_up, exp_w_down)
        h = layer_norm(DEEPNORM_ALPHA * h + ffn, ln2_g, ln2_b)
    return h
```

```cpp
#include <hip/hip_runtime.h>
#include <stdint.h>
#include <math.h>

typedef unsigned short bf16_t;
typedef float f32x4 __attribute__((ext_vector_type(4)));

constexpr int T = 32768, D = 1024, SEQ = 2048, NBATCH = 16;
constexpr int DRG = 512, NPROJ = 2560, NE = 32, DE = 256, NGRP = 4, EPG = 8;
constexpr float LN_EPS = 1e-5f;
constexpr float ALPHA = 1.189207115002721f;
constexpr int SLOT_ROWS = 2 * T + NE * 256;

constexpr size_t MiB = 1u << 20;
constexpr size_t WS_CTL = 0;
constexpr size_t CTL_BYTES = 1 * MiB;
constexpr size_t WS_VEC = 1 * MiB;
constexpr size_t WS_WIN = 2 * MiB;
constexpr size_t WS_WOUT = 7 * MiB;
constexpr size_t WS_WR = 9 * MiB;
constexpr size_t WS_WGU = 10 * MiB;
constexpr size_t WS_WD = 42 * MiB;
constexpr size_t WS_XB = 60 * MiB;
constexpr size_t WS_PROJ = 124 * MiB;
constexpr size_t WS_Y = 284 * MiB;
constexpr size_t WS_Z = 348 * MiB;
constexpr size_t WS_HID = 412 * MiB;
constexpr size_t WS_SLOT = 448 * MiB;
constexpr size_t WS_TOKSLOT = 464 * MiB;
constexpr size_t WS_PSTATS = 465 * MiB;
constexpr size_t WS_END = 467 * MiB;

constexpr int V_SR = 0, V_TR = 256, V_SGU = 512, V_TGU = V_SGU + NE * 512, V_SP = V_TGU + NE * 512, V_BASE = V_SP + 512;

__device__ __forceinline__ unsigned f2bf(float f) { unsigned u = __builtin_bit_cast(unsigned, f); return (u + 0x7fffu + ((u >> 16) & 1u)) >> 16; }
__device__ __forceinline__ float bf2f(unsigned h) { return __builtin_bit_cast(float, (h & 0xffffu) << 16); }
__device__ __forceinline__ float sigmoidf_(float x) { return 1.f / (1.f + __expf(-x)); }
__device__ __forceinline__ float gelu_tanh(float x) { const float u = 0.7978845608028654f * (x + 0.044715f * x * x * x); return 0.5f * x * (1.f + tanhf(u)); }

__global__ void k_cvt_x(const float* __restrict__ x, bf16_t* __restrict__ xb, size_t n4) {
    for (size_t i = blockIdx.x * (size_t)blockDim.x + threadIdx.x; i < n4; i += (size_t)gridDim.x * blockDim.x) {
        const f32x4 v = ((const f32x4*)x)[i];
        uint2 o; o.x = f2bf(v.x) | (f2bf(v.y) << 16); o.y = f2bf(v.z) | (f2bf(v.w) << 16);
        ((uint2*)xb)[i] = o;
    }
}
__global__ void k_tconv(const float* __restrict__ W, int K, int N, size_t wbs, bf16_t* __restrict__ WT, size_t tbs, const float* __restrict__ scale, int blk, int stride, int off) {
    __shared__ float tile[32][33];
    const int e = blockIdx.z; W += e * wbs; WT += e * tbs;
    const int n0 = blockIdx.x * 32, k0 = blockIdx.y * 32, tx = threadIdx.x, ty = threadIdx.y;
    for (int j = ty; j < 32; j += 8) { const int k = k0 + j, n = n0 + tx; tile[j][tx] = (scale ? scale[k] : 1.f) * W[(size_t)k * N + n]; }
    __syncthreads();
    for (int j = ty; j < 32; j += 8) { const int n = n0 + j, k = k0 + tx; const int dr = (n / blk) * stride + off + n % blk; WT[(size_t)dr * K + k] = (bf16_t)f2bf(tile[tx][j]); }
}
__global__ void k_zero16(bf16_t* p, size_t n) { for (size_t i = blockIdx.x * (size_t)blockDim.x + threadIdx.x; i < n; i += (size_t)gridDim.x * blockDim.x) p[i] = 0; }
__global__ void k_foldvec(const float* __restrict__ W, int K, int N, size_t wbs, const float* __restrict__ g, const float* __restrict__ b, const float* __restrict__ bias,
                          float* __restrict__ S, float* __restrict__ Tv, size_t vbs, int blk, int stride, int off) {
    const int e = blockIdx.y; W += e * wbs; S += e * vbs; Tv += e * vbs;
    const int n = blockIdx.x * blockDim.x + threadIdx.x; if (n >= N) return;
    float s = 0.f, t = 0.f;
    for (int k = 0; k < K; ++k) { const float w = W[(size_t)k * N + n]; s += g[k] * w; t += b[k] * w; }
    const int dr = (n / blk) * stride + off + n % blk;
    S[dr] = s; Tv[dr] = t + (bias ? bias[n] : 0.f);
}
__global__ void k_sp(const float* __restrict__ lam, float* __restrict__ sp) { const int c = threadIdx.x + blockIdx.x * blockDim.x; if (c < DRG) sp[c] = 8.0f * log1pf(expf(-lam[c])); }

template <class F> __global__ void __launch_bounds__(256) k_ngemm(F f) {
    __shared__ float As[64][33], Bs[64][33];
    if (!f.setup()) return;
    const int tid = threadIdx.x, tx = tid & 15, ty = tid >> 4;
    const int lr = tid >> 2, lk = (tid & 3) * 8;
    const bf16_t* ap = f.arow(lr); const bf16_t* bp = f.brow(lr);
    float acc[4][4] = {};
    const int K = f.K();
    for (int k0 = 0; k0 < K; k0 += 32) {
        uint4 av = make_uint4(0, 0, 0, 0), bv = make_uint4(0, 0, 0, 0);
        if (ap) av = *(const uint4*)(ap + k0 + lk);
        if (bp) bv = *(const uint4*)(bp + k0 + lk);
        const unsigned aw[4] = {av.x, av.y, av.z, av.w}, bw[4] = {bv.x, bv.y, bv.z, bv.w};
#pragma unroll
        for (int j = 0; j < 4; ++j) { As[lr][lk + 2 * j] = bf2f(aw[j]); As[lr][lk + 2 * j + 1] = bf2f(aw[j] >> 16); Bs[lr][lk + 2 * j] = bf2f(bw[j]); Bs[lr][lk + 2 * j + 1] = bf2f(bw[j] >> 16); }
        __syncthreads();
#pragma unroll 8
        for (int k = 0; k < 32; ++k) {
            float a[4], b[4];
#pragma unroll
            for (int i = 0; i < 4; ++i) { a[i] = As[ty * 4 + i][k]; b[i] = Bs[tx * 4 + i][k]; }
#pragma unroll
            for (int i = 0; i < 4; ++i)
#pragma unroll
                for (int j = 0; j < 4; ++j) acc[i][j] += a[i] * b[j];
        }
        __syncthreads();
    }
#pragma unroll
    for (int i = 0; i < 4; ++i)
#pragma unroll
        for (int j = 0; j < 4; ++j) f.out(ty * 4 + i, tx * 4 + j, acc[i][j]);
}

struct FProj {
    const bf16_t* A; const bf16_t* Bt; bf16_t* O; int r0, c0;
    __device__ bool setup() { r0 = blockIdx.y * 64; c0 = blockIdx.x * 64; return true; }
    __device__ const bf16_t* arow(int r) const { return A + (size_t)(r0 + r) * D; }
    __device__ const bf16_t* brow(int c) const { return Bt + (size_t)(c0 + c) * D; }
    __device__ int K() const { return D; }
    __device__ void out(int r, int c, float v) const { O[(size_t)(r0 + r) * NPROJ + c0 + c] = (bf16_t)f2bf(v); }
};
struct FOut {
    const bf16_t* A; const bf16_t* Bt; const bf16_t* XB; bf16_t* Z; int r0, c0;
    __device__ bool setup() { r0 = blockIdx.y * 64; c0 = blockIdx.x * 64; return true; }
    __device__ const bf16_t* arow(int r) const { return A + (size_t)(r0 + r) * D; }
    __device__ const bf16_t* brow(int c) const { return Bt + (size_t)(c0 + c) * D; }
    __device__ int K() const { return D; }
    __device__ void out(int r, int c, float v) const { const size_t i = (size_t)(r0 + r) * D + c0 + c; Z[i] = (bf16_t)f2bf(ALPHA * bf2f(XB[i]) + v); }
};
struct FGateUp {
    const bf16_t* Z; const bf16_t* WGU; const float4* SLOT; const int* cnt; const int* base; const float* SGU; const float* TGU; float* GU; int e, p0, c0, ne;
    __device__ bool setup() { e = blockIdx.z; ne = cnt[e]; p0 = blockIdx.y * 64; c0 = blockIdx.x * 64; return p0 < ne; }
    __device__ const bf16_t* arow(int r) const { const int pos = p0 + r; if (pos >= ne) return nullptr; const int tok = __builtin_bit_cast(int, SLOT[(size_t)e * T + pos].x); return Z + (size_t)tok * D; }
    __device__ const bf16_t* brow(int c) const { return WGU + ((size_t)e * 512 + c0 + c) * D; }
    __device__ int K() const { return D; }
    __device__ void out(int r, int c, float v) const { const int pos = p0 + r; if (pos >= ne) return; const float4 si = SLOT[(size_t)e * T + pos];
        const int n = c0 + c; GU[(size_t)(base[e] + pos) * 512 + n] = si.y * (v - si.z * SGU[e * 512 + n]) + TGU[e * 512 + n]; }
};
struct FDown {
    const bf16_t* HID; const bf16_t* WD; const int* cnt; const int* base; bf16_t* C; int e, p0, c0, ne;
    __device__ bool setup() { e = blockIdx.z; ne = cnt[e]; p0 = blockIdx.y * 64; c0 = blockIdx.x * 64; return p0 < ne; }
    __device__ const bf16_t* arow(int r) const { const int pos = p0 + r; if (pos >= ne) return nullptr; return HID + (size_t)(base[e] + pos) * DE; }
    __device__ const bf16_t* brow(int c) const { return WD + ((size_t)e * D + c0 + c) * DE; }
    __device__ int K() const { return DE; }
    __device__ void out(int r, int c, float v) const { const int pos = p0 + r; if (pos >= ne) return; C[(size_t)(base[e] + pos) * D + c0 + c] = (bf16_t)f2bf(v); }
};

__global__ void __launch_bounds__(64) k_mix_rg(const bf16_t* __restrict__ PROJ, const float* __restrict__ cw, const float* __restrict__ cb, const float* __restrict__ Wa, const float* __restrict__ ba,
                                               const float* __restrict__ Wx, const float* __restrict__ bx, const float* __restrict__ sp, bf16_t* __restrict__ Y) {
    __shared__ float wa[64][64], wx[64][64], xs[64];
    const int b = blockIdx.x >> 3, h = blockIdx.x & 7, lane = threadIdx.x, c = h * 64 + lane;
    for (int i = 0; i < 64; ++i) { wa[i][lane] = Wa[(h * 64 + i) * 64 + lane]; wx[i][lane] = Wx[(h * 64 + i) * 64 + lane]; }
    const float w0 = cw[0 * DRG + c], w1 = cw[1 * DRG + c], w2 = cw[2 * DRG + c], w3 = cw[3 * DRG + c], cbias = cb[c], bac = ba[c], bxc = bx[c], spc = sp[c];
    float x0 = 0.f, x1 = 0.f, x2 = 0.f, hs = 0.f;
    __syncthreads();
    for (int t = 0; t < SEQ; ++t) {
        const size_t row = (size_t)b * SEQ + t;
        const float x3 = bf2f(PROJ[row * NPROJ + c]);
        const float xc = cbias + w0 * x0 + w1 * x1 + w2 * x2 + w3 * x3;
        x0 = x1; x1 = x2; x2 = x3;
        xs[lane] = xc;
        __syncthreads();
        float ra = bac, rx = bxc;
#pragma unroll 8
        for (int i = 0; i < 64; ++i) { const float v = xs[i]; ra += v * wa[i][lane]; rx += v * wx[i][lane]; }
        const float r = sigmoidf_(ra), ii = sigmoidf_(rx);
        const float la = -spc * r, a = expf(la), mult = sqrtf(-expm1f(2.f * la));
        hs = a * hs + mult * (ii * xc);
        const float gate = bf2f(PROJ[row * NPROJ + DRG + c]);
        Y[row * D + c] = (bf16_t)f2bf(hs * gelu_tanh(gate));
        __syncthreads();
    }
}
__global__ void k_mix_sc(const bf16_t* __restrict__ PROJ, const float* __restrict__ scw, bf16_t* __restrict__ Y) {
    const size_t i = blockIdx.x * (size_t)blockDim.x + threadIdx.x; if (i >= (size_t)T * DRG) return;
    const int c = (int)(i % DRG); const size_t row = i / DRG; const int t = (int)(row % SEQ);
    float s = 0.f;
#pragma unroll
    for (int k = 0; k < 3; ++k) { const int tt = t - 2 + k; if (tt >= 0) { const size_t r2 = row - 2 + k; s += scw[k * DRG + c] * (bf2f(PROJ[r2 * NPROJ + 1536 + c]) * bf2f(PROJ[r2 * NPROJ + 2048 + c])); } }
    Y[row * D + DRG + c] = (bf16_t)f2bf(bf2f(PROJ[row * NPROJ + 1024 + c]) * s);
}
__global__ void k_pstats(const bf16_t* __restrict__ Z, float2* __restrict__ PS) {
    const size_t i = blockIdx.x * (size_t)blockDim.x + threadIdx.x; if (i >= (size_t)T * 4) return;
    const bf16_t* p = Z + (i >> 2) * D + (i & 3) * 256; float s = 0.f, q = 0.f;
    for (int k = 0; k < 256; ++k) { const float v = bf2f(p[k]); s += v; q += v * v; }
    PS[i] = make_float2(s, q);
}
__device__ __forceinline__ void row_stats(const float2* PS, int t, float& mu, float& rstd) {
    const float2 a = PS[t * 4 + 0], b = PS[t * 4 + 1], c = PS[t * 4 + 2], d = PS[t * 4 + 3];
    mu = ((a.x + b.x) + (c.x + d.x)) * (1.f / D); const float var = ((a.y + b.y) + (c.y + d.y)) * (1.f / D) - mu * mu; rstd = 1.f / sqrtf(fmaxf(var, 0.f) + LN_EPS);
}
__global__ void __launch_bounds__(64) k_router(const bf16_t* __restrict__ Z, const bf16_t* __restrict__ WR, const float2* __restrict__ PS, const float* __restrict__ SR, const float* __restrict__ TR,
                                               int* __restrict__ cnt, float4* __restrict__ SLOT, int* __restrict__ TOKSLOT) {
    __shared__ float lg[64];
    const int t = blockIdx.x, lane = threadIdx.x;
    float mu, rstd; row_stats(PS, t, mu, rstd);
    if (lane < 36) { float s = 0.f; const bf16_t* z = Z + (size_t)t * D; const bf16_t* w = WR + (size_t)lane * D;
        for (int k = 0; k < D; ++k) s += bf2f(z[k]) * bf2f(w[k]);
        lg[lane] = rstd * (s - mu * SR[lane]) + TR[lane]; }
    __syncthreads();
    if (lane == 0) {
        int g = 0; float gm = lg[0];
        for (int j = 1; j < NGRP; ++j) if (lg[j] > gm) { gm = lg[j]; g = j; }
        float den = 0.f; for (int j = 0; j < NGRP; ++j) den += expf(lg[j] - gm);
        const float gp = 1.f / den;
        const float* el = lg + 4 + g * EPG;
        int i1 = 0; float v1 = el[0];
        for (int j = 1; j < EPG; ++j) if (el[j] > v1) { v1 = el[j]; i1 = j; }
        int i2 = -1; float v2 = -INFINITY;
        for (int j = 0; j < EPG; ++j) if (j != i1 && el[j] > v2) { v2 = el[j]; i2 = j; }
        const float e2 = expf(v2 - v1), w1 = gp / (1.f + e2), w2 = gp * e2 / (1.f + e2);
        const int ea = g * EPG + i1, eb = g * EPG + i2;
        const int pa = atomicAdd(&cnt[ea], 1), pb = atomicAdd(&cnt[eb], 1);
        SLOT[(size_t)ea * T + pa] = make_float4(__builtin_bit_cast(float, t), rstd, mu, w1);
        SLOT[(size_t)eb * T + pb] = make_float4(__builtin_bit_cast(float, t), rstd, mu, w2);
        TOKSLOT[t * 2 + 0] = ea * T + pa; TOKSLOT[t * 2 + 1] = eb * T + pb;
    }
}
__global__ void k_base(const int* __restrict__ cnt, int* __restrict__ base) { if (threadIdx.x == 0) { int s = 0; for (int e = 0; e < NE; ++e) { base[e] = s; s += (cnt[e] + 255) / 256 * 256; } base[NE] = s; } }
__global__ void k_hid(const float* __restrict__ GU, const float4* __restrict__ SLOT, const int* __restrict__ cnt, const int* __restrict__ base, bf16_t* __restrict__ HID) {
    const int e = blockIdx.z, pos = blockIdx.y, f = threadIdx.x; if (pos >= cnt[e]) return;
    const size_t row = (size_t)base[e] + pos; const int j = f >> 7, fl = f & 127;
    const float g = GU[row * 512 + 256 * j + fl], u = GU[row * 512 + 256 * j + 128 + fl], cw = SLOT[(size_t)e * T + pos].w;
    HID[row * DE + f] = (bf16_t)f2bf(g * sigmoidf_(g) * u * cw);
}
__global__ void __launch_bounds__(64) k_final(const bf16_t* __restrict__ Z, const float2* __restrict__ PS, const int* __restrict__ TOKSLOT, const int* __restrict__ base, const bf16_t* __restrict__ C,
                                              const float* __restrict__ g1, const float* __restrict__ b1, const float* __restrict__ g2, const float* __restrict__ b2, float* __restrict__ out) {
    const int t = blockIdx.x, lane = threadIdx.x;
    float mu, rstd; row_stats(PS, t, mu, rstd);
    const int s1 = TOKSLOT[t * 2], s2 = TOKSLOT[t * 2 + 1];
    const size_t r1 = (size_t)base[s1 / T] + s1 % T, r2 = (size_t)base[s2 / T] + s2 % T;
    float v[16]; float s = 0.f;
#pragma unroll
    for (int j = 0; j < 16; ++j) { const int c = j * 64 + lane; const float h1 = (bf2f(Z[(size_t)t * D + c]) - mu) * rstd * g1[c] + b1[c];
        v[j] = ALPHA * h1 + bf2f(C[r1 * D + c]) + bf2f(C[r2 * D + c]); s += v[j]; }
    for (int o = 1; o < 64; o <<= 1) s += __shfl_xor(s, o);
    const float m2 = s * (1.f / D); float q = 0.f;
#pragma unroll
    for (int j = 0; j < 16; ++j) { const float d = v[j] - m2; q += d * d; }
    for (int o = 1; o < 64; o <<= 1) q += __shfl_xor(q, o);
    const float r2s = 1.f / sqrtf(q * (1.f / D) + LN_EPS);
#pragma unroll
    for (int j = 0; j < 16; ++j) { const int c = j * 64 + lane; out[(size_t)t * D + c] = (v[j] - m2) * r2s * g2[c] + b2[c]; }
}

__global__ void k_tconv4(const float* __restrict__ W, const float* __restrict__ g, bf16_t* __restrict__ WT) {
    const int i = blockIdx.x * blockDim.x + threadIdx.x; if (i >= 4 * D) return; const int n = i / D, k = i % D; WT[(size_t)n * D + k] = (bf16_t)f2bf(g[k] * W[k * 4 + n]);
}

extern "C" void kernel_launch(void* const* d_in, const int* in_sizes, int n_in, void* d_out, int out_size, void* d_ws, size_t ws_size, hipStream_t stream) {
    if (ws_size < WS_END) return;
    const float* x = (const float*)d_in[0]; const float* w_in = (const float*)d_in[1]; const float* rg_cw = (const float*)d_in[2]; const float* rg_cb = (const float*)d_in[3];
    const float* Wa = (const float*)d_in[4]; const float* ba = (const float*)d_in[5]; const float* Wx = (const float*)d_in[6]; const float* bx = (const float*)d_in[7];
    const float* lam = (const float*)d_in[8]; const float* sc_cw = (const float*)d_in[9]; const float* w_out = (const float*)d_in[10]; const float* g1 = (const float*)d_in[11]; const float* b1 = (const float*)d_in[12];
    const float* rgw = (const float*)d_in[13]; const float* rgb = (const float*)d_in[14]; const float* rew = (const float*)d_in[15]; const float* reb = (const float*)d_in[16];
    const float* wg = (const float*)d_in[17]; const float* wu = (const float*)d_in[18]; const float* wd = (const float*)d_in[19]; const float* g2 = (const float*)d_in[20]; const float* b2 = (const float*)d_in[21];
    char* ws = (char*)d_ws;
    int* cnt = (int*)(ws + WS_CTL); float* vec = (float*)(ws + WS_VEC); int* base = (int*)(vec + V_BASE);
    bf16_t* WIN = (bf16_t*)(ws + WS_WIN); bf16_t* WOUT = (bf16_t*)(ws + WS_WOUT); bf16_t* WR = (bf16_t*)(ws + WS_WR); bf16_t* WGU = (bf16_t*)(ws + WS_WGU); bf16_t* WD = (bf16_t*)(ws + WS_WD);
    bf16_t* XB = (bf16_t*)(ws + WS_XB); bf16_t* PROJ = (bf16_t*)(ws + WS_PROJ); float* GU = (float*)(ws + WS_PROJ); bf16_t* CONTRIB = (bf16_t*)(ws + WS_PROJ);
    bf16_t* Y = (bf16_t*)(ws + WS_Y); bf16_t* Z = (bf16_t*)(ws + WS_Z); bf16_t* HID = (bf16_t*)(ws + WS_HID);
    float4* SLOT = (float4*)(ws + WS_SLOT); int* TOKSLOT = (int*)(ws + WS_TOKSLOT); float2* PS = (float2*)(ws + WS_PSTATS);

    hipMemsetAsync(ws + WS_CTL, 0, CTL_BYTES, stream);
    k_cvt_x<<<2048, 256, 0, stream>>>(x, XB, (size_t)T * D / 4);
    k_tconv<<<dim3(NPROJ / 32, D / 32, 1), dim3(32, 8), 0, stream>>>(w_in, D, NPROJ, 0, WIN, 0, nullptr, NPROJ, 0, 0);
    k_tconv<<<dim3(D / 32, D / 32, 1), dim3(32, 8), 0, stream>>>(w_out, D, D, 0, WOUT, 0, nullptr, D, 0, 0);
    k_zero16<<<256, 256, 0, stream>>>(WR, (size_t)256 * D);
    k_tconv<<<dim3(1, D / 32, 1), dim3(32, 8), 0, stream>>>(rew, D, 32, 0, WR, 0, g1, 32, 0, 4);
    k_foldvec<<<dim3(1, 1), 64, 0, stream>>>(rew, D, 32, 0, g1, b1, reb, vec + V_SR, vec + V_TR, 0, 32, 0, 4);
    k_foldvec<<<dim3(1, 1), 64, 0, stream>>>(rgw, D, 4, 0, g1, b1, rgb, vec + V_SR, vec + V_TR, 0, 4, 0, 0);
    k_tconv<<<dim3(DE / 32, D / 32, NE), dim3(32, 8), 0, stream>>>(wg, D, DE, (size_t)D * DE, WGU, (size_t)512 * D, g1, 128, 256, 0);
    k_tconv<<<dim3(DE / 32, D / 32, NE), dim3(32, 8), 0, stream>>>(wu, D, DE, (size_t)D * DE, WGU, (size_t)512 * D, g1, 128, 256, 128);
    k_foldvec<<<dim3(1, NE), 256, 0, stream>>>(wg, D, DE, (size_t)D * DE, g1, b1, nullptr, vec + V_SGU, vec + V_TGU, 512, 128, 256, 0);
    k_foldvec<<<dim3(1, NE), 256, 0, stream>>>(wu, D, DE, (size_t)D * DE, g1, b1, nullptr, vec + V_SGU, vec + V_TGU, 512, 128, 256, 128);
    k_tconv<<<dim3(D / 32, DE / 32, NE), dim3(32, 8), 0, stream>>>(wd, DE, D, (size_t)DE * D, WD, (size_t)D * DE, nullptr, D, 0, 0);
    k_sp<<<2, 256, 0, stream>>>(lam, vec + V_SP);
    k_tconv4<<<16, 256, 0, stream>>>(rgw, g1, WR);
    { FProj f{XB, WIN, PROJ, 0, 0}; k_ngemm<<<dim3(NPROJ / 64, T / 64), 256, 0, stream>>>(f); }
    k_mix_rg<<<NBATCH * 8, 64, 0, stream>>>(PROJ, rg_cw, rg_cb, Wa, ba, Wx, bx, vec + V_SP, Y);
    k_mix_sc<<<(unsigned)(((size_t)T * DRG + 255) / 256), 256, 0, stream>>>(PROJ, sc_cw, Y);
    { FOut f{Y, WOUT, XB, Z, 0, 0}; k_ngemm<<<dim3(D / 64, T / 64), 256, 0, stream>>>(f); }
    k_pstats<<<T * 4 / 256, 256, 0, stream>>>(Z, PS);
    k_router<<<T, 64, 0, stream>>>(Z, WR, PS, vec + V_SR, vec + V_TR, cnt, SLOT, TOKSLOT);
    k_base<<<1, 64, 0, stream>>>(cnt, base);
    { FGateUp f{Z, WGU, SLOT, cnt, base, vec + V_SGU, vec + V_TGU, GU, 0, 0, 0, 0}; k_ngemm<<<dim3(512 / 64, T / 64, NE), 256, 0, stream>>>(f); }
    k_hid<<<dim3(1, T, NE), 256, 0, stream>>>(GU, SLOT, cnt, base, HID);
    { FDown f{HID, WD, cnt, base, CONTRIB, 0, 0, 0, 0}; k_ngemm<<<dim3(D / 64, T / 64, NE), 256, 0, stream>>>(f); }
    k_final<<<T, 64, 0, stream>>>(Z, PS, TOKSLOT, base, CONTRIB, g1, b1, g2, b2, (float*)d_out);
}
```

```cpp
#include <hip/hip_runtime.h>
#include <stdint.h>
#include <math.h>
#define MK_ALL 1
#define MK_P0 1
#define MK_P1 1
#define MK_P2 1
#define MK_P3 1
#define MK_P4 1
#define MK_P5 1
#define MK_P6 1
#define MK_P7 1

typedef unsigned short bf16_t;
typedef float f32x4 __attribute__((ext_vector_type(4)));

constexpr int T = 32768, D = 1024, SEQ = 2048, NBATCH = 16;
constexpr int DRG = 512, NPROJ = 2560, NE = 32, DE = 256, NGRP = 4, EPG = 8;
constexpr float LN_EPS = 1e-5f;
constexpr float ALPHA = 1.189207115002721f;
constexpr int SLOT_ROWS = 2 * T + NE * 256;

constexpr size_t MiB = 1u << 20;
constexpr size_t WS_CTL = 0;
constexpr size_t CTL_BYTES = 1 * MiB;
constexpr size_t WS_VEC = 1 * MiB;
constexpr size_t WS_WIN = 2 * MiB;
constexpr size_t WS_WOUT = 7 * MiB;
constexpr size_t WS_WR = 9 * MiB;
constexpr size_t WS_WGU = 10 * MiB;
constexpr size_t WS_WD = 42 * MiB;
constexpr size_t WS_XB = 60 * MiB;
constexpr size_t WS_PROJ = 124 * MiB;
constexpr size_t WS_Y = 284 * MiB;
constexpr size_t WS_Z = 348 * MiB;
constexpr size_t WS_HID = 412 * MiB;
constexpr size_t WS_SLOT = 448 * MiB;
constexpr size_t WS_TOKSLOT = 464 * MiB;
constexpr size_t WS_PSTATS = 465 * MiB;
constexpr size_t WS_END = 470 * MiB;

constexpr int V_SR = 0, V_TR = 256, V_SGU = 512, V_TGU = V_SGU + NE * 512, V_SP = V_TGU + NE * 512, V_BASE = V_SP + 512;

__device__ __forceinline__ unsigned f2bf(float f) { unsigned u = __builtin_bit_cast(unsigned, f); return (u + 0x7fffu + ((u >> 16) & 1u)) >> 16; }
__device__ __forceinline__ float bf2f(unsigned h) { return __builtin_bit_cast(float, (h & 0xffffu) << 16); }
__device__ __forceinline__ float sigmoidf_(float x) { return 1.f / (1.f + __expf(-x)); }
__device__ __forceinline__ float gelu_tanh(float x) { const float u = 0.7978845608028654f * (x + 0.044715f * x * x * x); return 0.5f * x * (1.f + tanhf(u)); }

__global__ void k_cvt_x(const float* __restrict__ x, bf16_t* __restrict__ xb, size_t n4) {
    for (size_t i = blockIdx.x * (size_t)blockDim.x + threadIdx.x; i < n4; i += (size_t)gridDim.x * blockDim.x) {
        const f32x4 v = ((const f32x4*)x)[i];
        uint2 o; o.x = f2bf(v.x) | (f2bf(v.y) << 16); o.y = f2bf(v.z) | (f2bf(v.w) << 16);
        ((uint2*)xb)[i] = o;
    }
}
__global__ void k_tconv(const float* __restrict__ W, int K, int N, size_t wbs, bf16_t* __restrict__ WT, size_t tbs, const float* __restrict__ scale, int blk, int stride, int off) {
    __shared__ float tile[32][33];
    const int e = blockIdx.z; W += e * wbs; WT += e * tbs;
    const int n0 = blockIdx.x * 32, k0 = blockIdx.y * 32, tx = threadIdx.x, ty = threadIdx.y;
    for (int j = ty; j < 32; j += 8) { const int k = k0 + j, n = n0 + tx; tile[j][tx] = (scale ? scale[k] : 1.f) * W[(size_t)k * N + n]; }
    __syncthreads();
    for (int j = ty; j < 32; j += 8) { const int n = n0 + j, k = k0 + tx; const int dr = (n / blk) * stride + off + n % blk; WT[(size_t)dr * K + k] = (bf16_t)f2bf(tile[tx][j]); }
}
__global__ void k_zero16(bf16_t* p, size_t n) { for (size_t i = blockIdx.x * (size_t)blockDim.x + threadIdx.x; i < n; i += (size_t)gridDim.x * blockDim.x) p[i] = 0; }
__global__ void k_foldvec(const float* __restrict__ W, int K, int N, size_t wbs, const float* __restrict__ g, const float* __restrict__ b, const float* __restrict__ bias,
                          float* __restrict__ S, float* __restrict__ Tv, size_t vbs, int blk, int stride, int off) {
    const int e = blockIdx.y; W += e * wbs; S += e * vbs; Tv += e * vbs;
    const int n = blockIdx.x * blockDim.x + threadIdx.x; if (n >= N) return;
    float s = 0.f, t = 0.f;
    for (int k = 0; k < K; ++k) { const float w = W[(size_t)k * N + n]; s += g[k] * w; t += b[k] * w; }
    const int dr = (n / blk) * stride + off + n % blk;
    S[dr] = s; Tv[dr] = t + (bias ? bias[n] : 0.f);
}
__global__ void k_sp(const float* __restrict__ lam, float* __restrict__ sp) { const int c = threadIdx.x + blockIdx.x * blockDim.x; if (c < DRG) sp[c] = 8.0f * log1pf(expf(-lam[c])); }

template <class F> __global__ void __launch_bounds__(256) k_ngemm(F f) {
    __shared__ float As[64][33], Bs[64][33];
    if (!f.setup()) return;
    const int tid = threadIdx.x, tx = tid & 15, ty = tid >> 4;
    const int lr = tid >> 2, lk = (tid & 3) * 8;
    const bf16_t* ap = f.arow(lr); const bf16_t* bp = f.brow(lr);
    float acc[4][4] = {};
    const int K = f.K();
    for (int k0 = 0; k0 < K; k0 += 32) {
        uint4 av = make_uint4(0, 0, 0, 0), bv = make_uint4(0, 0, 0, 0);
        if (ap) av = *(const uint4*)(ap + k0 + lk);
        if (bp) bv = *(const uint4*)(bp + k0 + lk);
        const unsigned aw[4] = {av.x, av.y, av.z, av.w}, bw[4] = {bv.x, bv.y, bv.z, bv.w};
#pragma unroll
        for (int j = 0; j < 4; ++j) { As[lr][lk + 2 * j] = bf2f(aw[j]); As[lr][lk + 2 * j + 1] = bf2f(aw[j] >> 16); Bs[lr][lk + 2 * j] = bf2f(bw[j]); Bs[lr][lk + 2 * j + 1] = bf2f(bw[j] >> 16); }
        __syncthreads();
#pragma unroll 8
        for (int k = 0; k < 32; ++k) {
            float a[4], b[4];
#pragma unroll
            for (int i = 0; i < 4; ++i) { a[i] = As[ty * 4 + i][k]; b[i] = Bs[tx * 4 + i][k]; }
#pragma unroll
            for (int i = 0; i < 4; ++i)
#pragma unroll
                for (int j = 0; j < 4; ++j) acc[i][j] += a[i] * b[j];
        }
        __syncthreads();
    }
#pragma unroll
    for (int i = 0; i < 4; ++i)
#pragma unroll
        for (int j = 0; j < 4; ++j) f.out(ty * 4 + i, tx * 4 + j, acc[i][j]);
}

struct FProj {
    const bf16_t* A; const bf16_t* Bt; bf16_t* O; int r0, c0;
    __device__ bool setup() { r0 = blockIdx.y * 64; c0 = blockIdx.x * 64; return true; }
    __device__ const bf16_t* arow(int r) const { return A + (size_t)(r0 + r) * D; }
    __device__ const bf16_t* brow(int c) const { return Bt + (size_t)(c0 + c) * D; }
    __device__ int K() const { return D; }
    __device__ void out(int r, int c, float v) const { O[(size_t)(r0 + r) * NPROJ + c0 + c] = (bf16_t)f2bf(v); }
};
struct FOut {
    const bf16_t* A; const bf16_t* Bt; const bf16_t* XB; bf16_t* Z; int r0, c0;
    __device__ bool setup() { r0 = blockIdx.y * 64; c0 = blockIdx.x * 64; return true; }
    __device__ const bf16_t* arow(int r) const { return A + (size_t)(r0 + r) * D; }
    __device__ const bf16_t* brow(int c) const { return Bt + (size_t)(c0 + c) * D; }
    __device__ int K() const { return D; }
    __device__ void out(int r, int c, float v) const { const size_t i = (size_t)(r0 + r) * D + c0 + c; Z[i] = (bf16_t)f2bf(ALPHA * bf2f(XB[i]) + v); }
};
struct FGateUp {
    const bf16_t* Z; const bf16_t* WGU; const float4* SLOT; const int* cnt; const int* base; const float* SGU; const float* TGU; float* GU; int e, p0, c0, ne;
    __device__ bool setup() { e = blockIdx.z; ne = cnt[e]; p0 = blockIdx.y * 64; c0 = blockIdx.x * 64; return p0 < ne; }
    __device__ const bf16_t* arow(int r) const { const int pos = p0 + r; if (pos >= ne) return nullptr; const int tok = __builtin_bit_cast(int, SLOT[(size_t)e * T + pos].x); return Z + (size_t)tok * D; }
    __device__ const bf16_t* brow(int c) const { return WGU + ((size_t)e * 512 + c0 + c) * D; }
    __device__ int K() const { return D; }
    __device__ void out(int r, int c, float v) const { const int pos = p0 + r; if (pos >= ne) return; const float4 si = SLOT[(size_t)e * T + pos];
        const int n = c0 + c; GU[(size_t)(base[e] + pos) * 512 + n] = si.y * (v - si.z * SGU[e * 512 + n]) + TGU[e * 512 + n]; }
};
struct FDown {
    const bf16_t* HID; const bf16_t* WD; const int* cnt; const int* base; bf16_t* C; int e, p0, c0, ne;
    __device__ bool setup() { e = blockIdx.z; ne = cnt[e]; p0 = blockIdx.y * 64; c0 = blockIdx.x * 64; return p0 < ne; }
    __device__ const bf16_t* arow(int r) const { const int pos = p0 + r; if (pos >= ne) return nullptr; return HID + (size_t)(base[e] + pos) * DE; }
    __device__ const bf16_t* brow(int c) const { return WD + ((size_t)e * D + c0 + c) * DE; }
    __device__ int K() const { return DE; }
    __device__ void out(int r, int c, float v) const { const int pos = p0 + r; if (pos >= ne) return; C[(size_t)(base[e] + pos) * D + c0 + c] = (bf16_t)f2bf(v); }
};

__global__ void __launch_bounds__(64) k_mix_rg(const bf16_t* __restrict__ PROJ, const float* __restrict__ cw, const float* __restrict__ cb, const float* __restrict__ Wa, const float* __restrict__ ba,
                                               const float* __restrict__ Wx, const float* __restrict__ bx, const float* __restrict__ sp, bf16_t* __restrict__ Y) {
    __shared__ float wa[64][64], wx[64][64], xs[64];
    const int b = blockIdx.x >> 3, h = blockIdx.x & 7, lane = threadIdx.x, c = h * 64 + lane;
    for (int i = 0; i < 64; ++i) { wa[i][lane] = Wa[(h * 64 + i) * 64 + lane]; wx[i][lane] = Wx[(h * 64 + i) * 64 + lane]; }
    const float w0 = cw[0 * DRG + c], w1 = cw[1 * DRG + c], w2 = cw[2 * DRG + c], w3 = cw[3 * DRG + c], cbias = cb[c], bac = ba[c], bxc = bx[c], spc = sp[c];
    float x0 = 0.f, x1 = 0.f, x2 = 0.f, hs = 0.f;
    __syncthreads();
    for (int t = 0; t < SEQ; ++t) {
        const size_t row = (size_t)b * SEQ + t;
        const float x3 = bf2f(PROJ[row * NPROJ + c]);
        const float xc = cbias + w0 * x0 + w1 * x1 + w2 * x2 + w3 * x3;
        x0 = x1; x1 = x2; x2 = x3;
        xs[lane] = xc;
        __syncthreads();
        float ra = bac, rx = bxc;
#pragma unroll 8
        for (int i = 0; i < 64; ++i) { const float v = xs[i]; ra += v * wa[i][lane]; rx += v * wx[i][lane]; }
        const float r = sigmoidf_(ra), ii = sigmoidf_(rx);
        const float la = -spc * r, a = expf(la), mult = sqrtf(-expm1f(2.f * la));
        hs = a * hs + mult * (ii * xc);
        const float gate = bf2f(PROJ[row * NPROJ + DRG + c]);
        Y[row * D + c] = (bf16_t)f2bf(hs * gelu_tanh(gate));
        __syncthreads();
    }
}
__global__ void k_mix_sc(const bf16_t* __restrict__ PROJ, const float* __restrict__ scw, bf16_t* __restrict__ Y) {
    const size_t i = blockIdx.x * (size_t)blockDim.x + threadIdx.x; if (i >= (size_t)T * DRG) return;
    const int c = (int)(i % DRG); const size_t row = i / DRG; const int t = (int)(row % SEQ);
    float s = 0.f;
#pragma unroll
    for (int k = 0; k < 3; ++k) { const int tt = t - 2 + k; if (tt >= 0) { const size_t r2 = row - 2 + k; s += scw[k * DRG + c] * (bf2f(PROJ[r2 * NPROJ + 1536 + c]) * bf2f(PROJ[r2 * NPROJ + 2048 + c])); } }
    Y[row * D + DRG + c] = (bf16_t)f2bf(bf2f(PROJ[row * NPROJ + 1024 + c]) * s);
}
__global__ void k_pstats(const bf16_t* __restrict__ Z, float2* __restrict__ PS) {
    const size_t i = blockIdx.x * (size_t)blockDim.x + threadIdx.x; if (i >= (size_t)T * 16) return;
    const int pn = (int)((i >> 2) & 3), wc = (int)(i & 3);
    const bf16_t* p = Z + (i >> 4) * D + pn * 256 + wc * 32; float s = 0.f, q = 0.f;
    for (int bj = 0; bj < 2; ++bj) for (int k = 0; k < 32; ++k) { const float v = bf2f(p[bj * 128 + k]); s += v; q += v * v; }
    PS[i] = make_float2(s, q);
}
__device__ __forceinline__ void row_stats(const float2* PS, int t, float& mu, float& rstd) {
    float s = 0.f, q = 0.f;
#pragma unroll
    for (int j = 0; j < 16; ++j) { const float2 a = PS[(size_t)t * 16 + j]; s += a.x; q += a.y; }
    mu = s * (1.f / D); const float var = q * (1.f / D) - mu * mu; rstd = 1.f / sqrtf(fmaxf(var, 0.f) + LN_EPS);
}
__global__ void __launch_bounds__(64) k_router(const bf16_t* __restrict__ Z, const bf16_t* __restrict__ WR, const float2* __restrict__ PS, const float* __restrict__ SR, const float* __restrict__ TR,
                                               int* __restrict__ cnt, float4* __restrict__ SLOT, int* __restrict__ TOKSLOT) {
    __shared__ float lg[64];
    const int t = blockIdx.x, lane = threadIdx.x;
    float mu, rstd; row_stats(PS, t, mu, rstd);
    if (lane < 36) { float s = 0.f; const bf16_t* z = Z + (size_t)t * D; const bf16_t* w = WR + (size_t)lane * D;
        for (int k = 0; k < D; ++k) s += bf2f(z[k]) * bf2f(w[k]);
        lg[lane] = rstd * (s - mu * SR[lane]) + TR[lane]; }
    __syncthreads();
    if (lane == 0) {
        int g = 0; float gm = lg[0];
        for (int j = 1; j < NGRP; ++j) if (lg[j] > gm) { gm = lg[j]; g = j; }
        float den = 0.f; for (int j = 0; j < NGRP; ++j) den += expf(lg[j] - gm);
        const float gp = 1.f / den;
        const float* el = lg + 4 + g * EPG;
        int i1 = 0; float v1 = el[0];
        for (int j = 1; j < EPG; ++j) if (el[j] > v1) { v1 = el[j]; i1 = j; }
        int i2 = -1; float v2 = -INFINITY;
        for (int j = 0; j < EPG; ++j) if (j != i1 && el[j] > v2) { v2 = el[j]; i2 = j; }
        const float e2 = expf(v2 - v1), w1 = gp / (1.f + e2), w2 = gp * e2 / (1.f + e2);
        const int ea = g * EPG + i1, eb = g * EPG + i2;
        const int pa = atomicAdd(&cnt[ea], 1), pb = atomicAdd(&cnt[eb], 1);
        SLOT[(size_t)ea * T + pa] = make_float4(__builtin_bit_cast(float, t), rstd, mu, w1);
        SLOT[(size_t)eb * T + pb] = make_float4(__builtin_bit_cast(float, t), rstd, mu, w2);
        TOKSLOT[t * 2 + 0] = ea * T + pa; TOKSLOT[t * 2 + 1] = eb * T + pb;
    }
}
__global__ void k_base(const int* __restrict__ cnt, int* __restrict__ base) { if (threadIdx.x == 0) { int s = 0; for (int e = 0; e < NE; ++e) { base[e] = s; s += (cnt[e] + 255) / 256 * 256; } base[NE] = s; } }
__global__ void k_hid(const float* __restrict__ GU, const float4* __restrict__ SLOT, const int* __restrict__ cnt, const int* __restrict__ base, bf16_t* __restrict__ HID) {
    const int e = blockIdx.z, pos = blockIdx.y, f = threadIdx.x; if (pos >= cnt[e]) return;
    const size_t row = (size_t)base[e] + pos; const int j = f >> 7, fl = f & 127;
    const float g = GU[row * 512 + 256 * j + fl], u = GU[row * 512 + 256 * j + 128 + fl], cw = SLOT[(size_t)e * T + pos].w;
    HID[row * DE + f] = (bf16_t)f2bf(g * sigmoidf_(g) * u * cw);
}
__global__ void __launch_bounds__(64) k_final(const bf16_t* __restrict__ Z, const float2* __restrict__ PS, const int* __restrict__ TOKSLOT, const int* __restrict__ base, const bf16_t* __restrict__ C,
                                              const float* __restrict__ g1, const float* __restrict__ b1, const float* __restrict__ g2, const float* __restrict__ b2, float* __restrict__ out) {
    const int t = blockIdx.x, lane = threadIdx.x;
    float mu, rstd; row_stats(PS, t, mu, rstd);
    const int s1 = TOKSLOT[t * 2], s2 = TOKSLOT[t * 2 + 1];
    const size_t r1 = (size_t)base[s1 / T] + s1 % T, r2 = (size_t)base[s2 / T] + s2 % T;
    float v[16]; float s = 0.f;
#pragma unroll
    for (int j = 0; j < 16; ++j) { const int c = j * 64 + lane; const float h1 = (bf2f(Z[(size_t)t * D + c]) - mu) * rstd * g1[c] + b1[c];
        v[j] = ALPHA * h1 + bf2f(C[r1 * D + c]) + bf2f(C[r2 * D + c]); s += v[j]; }
    for (int o = 1; o < 64; o <<= 1) s += __shfl_xor(s, o);
    const float m2 = s * (1.f / D); float q = 0.f;
#pragma unroll
    for (int j = 0; j < 16; ++j) { const float d = v[j] - m2; q += d * d; }
    for (int o = 1; o < 64; o <<= 1) q += __shfl_xor(q, o);
    const float r2s = 1.f / sqrtf(q * (1.f / D) + LN_EPS);
#pragma unroll
    for (int j = 0; j < 16; ++j) { const int c = j * 64 + lane; out[(size_t)t * D + c] = (v[j] - m2) * r2s * g2[c] + b2[c]; }
}

__global__ void k_tconv4(const float* __restrict__ W, const float* __restrict__ g, bf16_t* __restrict__ WT) {
    const int i = blockIdx.x * blockDim.x + threadIdx.x; if (i >= 4 * D) return; const int n = i / D, k = i % D; WT[(size_t)n * D + k] = (bf16_t)f2bf(g[k] * W[k * 4 + n]);
}


#define LAS __attribute__((address_space(3)))
#define GAS __attribute__((address_space(1)))
typedef short bf16x8 __attribute__((ext_vector_type(8)));
typedef unsigned u32x4 __attribute__((ext_vector_type(4)));
typedef float f32x2 __attribute__((ext_vector_type(2)));
namespace pg8 {
constexpr int BM = 256, BK = 64, HALF = 128, HTB = HALF * BK * 2, STAGE_BYTES = 8 * HTB, NXCD = 8, WGM = 8;
__host__ __device__ __forceinline__ int lds_byte(int r, int c) { const int st = (r >> 4) * 2 + (c >> 5), rr = r & 15, cc = c & 31, ob = rr * 64 + cc * 2; return st * 1024 + (ob ^ (((ob >> 9) & 1) << 5)); }
__host__ __device__ __forceinline__ void stage_rc(int b, int& R, int& C) { const int st = b / 1024, sb = b % 1024, swz = sb ^ (((sb >> 9) & 1) << 5); R = (st >> 1) * 16 + swz / 64; C = (st & 1) * 32 + (swz % 64) / 2; }
__host__ __device__ __forceinline__ int perm32(int rho) { const int n = rho >> 4, i = rho & 15; return 8 * (i >> 2) + 4 * n + (i & 3); }
__device__ __forceinline__ unsigned cvt_pk_bf16(float lo, float hi) { unsigned r; asm volatile("v_cvt_pk_bf16_f32 %0, %1, %2" : "=v"(r) : "v"(lo), "v"(hi)); return r; }

struct Unit { int pm, pn, e, tl; };

__device__ __forceinline__ int xcd_remap(int L, int nwg) { const int q = nwg / NXCD, r = nwg % NXCD, xcd = L % NXCD, off = L / NXCD; return (xcd < r ? xcd * (q + 1) : r * (q + 1) + (xcd - r) * q) + off; }
struct StaticOrder {
    int nM, nN, nwg, G, c;
    __device__ void init(int M, int N, int G_, int c_) { nM = M / BM; nN = N / BM; nwg = nM * nN; G = G_; c = c_; }
    __device__ bool next(int i, Unit& u) const {
        const long L = (long)i * G + c; if (L >= nwg) return false;
        const int wgid = xcd_remap((int)L, nwg);
        const int nig = WGM * nN, gid = wgid / nig, fm = gid * WGM, gsz = (nM - fm) < WGM ? (nM - fm) : WGM;
        u.pm = fm + ((wgid % nig) % gsz); u.pn = (wgid % nig) / gsz; u.e = 0; u.tl = 0; return true;
    }
};
struct MoeOrder {
    const LAS int* pref;
    int NP, nunits, G, c;
    __device__ bool next(int i, Unit& u) const {
        const long L = (long)i * G + c; if (L >= nunits) return false;
        const int wgid = xcd_remap((int)L, nunits);
        const int tg = wgid / NP, pl = wgid % NP;
        int e = 0; while (pref[e + 1] <= tg) ++e;
        e = __builtin_amdgcn_readfirstlane(e);
        u.pm = __builtin_amdgcn_readfirstlane(tg); u.e = e; u.tl = __builtin_amdgcn_readfirstlane(tg - pref[e]); u.pn = e * NP + pl; return true;
    }
};
struct DenseA { static constexpr bool GATHER = false; };
struct GatherA { static constexpr bool GATHER = true; const LAS int* toks; };

struct EpiBf16 {
    static constexpr bool PERM = true;
    bf16_t* O; int ldc; int cmask;
    __device__ __forceinline__ void operator()(const f32x4 (&acc)[2][2][4][2], const Unit& u, int wr, int wc, int fr, int fq) const {
        const int row0 = u.pm * BM + wr * 64 + fr, col0 = (u.pn & cmask) * BM + wc * 32 + 8 * fq;
#pragma unroll
        for (int ai = 0; ai < 2; ++ai)
#pragma unroll
            for (int m = 0; m < 4; ++m) { bf16_t* rowp = O + (size_t)(row0 + ai * HALF + m * 16) * ldc + col0;
#pragma unroll
                for (int bj = 0; bj < 2; ++bj) { const f32x4 v0 = acc[ai][bj][m][0], v1 = acc[ai][bj][m][1];
                    u32x4 w; w.x = cvt_pk_bf16(v0[0], v0[1]); w.y = cvt_pk_bf16(v0[2], v0[3]); w.z = cvt_pk_bf16(v1[0], v1[1]); w.w = cvt_pk_bf16(v1[2], v1[3]);
                    *(u32x4*)(rowp + bj * HALF) = w; } }
    }
};
struct EpiZ {
    static constexpr bool PERM = true;
    const bf16_t* XB; bf16_t* Z; float2* PS;
    __device__ __forceinline__ void operator()(const f32x4 (&acc)[2][2][4][2], const Unit& u, int wr, int wc, int fr, int fq) const {
        const int row0 = u.pm * BM + wr * 64 + fr, col0 = u.pn * BM + wc * 32 + 8 * fq;
#pragma unroll
        for (int ai = 0; ai < 2; ++ai)
#pragma unroll
            for (int m = 0; m < 4; ++m) { const int r = row0 + ai * HALF + m * 16; const size_t off = (size_t)r * D + col0; float s = 0.f, q = 0.f;
#pragma unroll
                for (int bj = 0; bj < 2; ++bj) { const u32x4 xv = *(const u32x4*)(XB + off + bj * HALF); const f32x4 v0 = acc[ai][bj][m][0], v1 = acc[ai][bj][m][1];
                    u32x4 w;
                    w.x = cvt_pk_bf16(ALPHA * bf2f(xv.x) + v0[0], ALPHA * bf2f(xv.x >> 16) + v0[1]); w.y = cvt_pk_bf16(ALPHA * bf2f(xv.y) + v0[2], ALPHA * bf2f(xv.y >> 16) + v0[3]);
                    w.z = cvt_pk_bf16(ALPHA * bf2f(xv.z) + v1[0], ALPHA * bf2f(xv.z >> 16) + v1[1]); w.w = cvt_pk_bf16(ALPHA * bf2f(xv.w) + v1[2], ALPHA * bf2f(xv.w >> 16) + v1[3]);
                    *(u32x4*)(Z + off + bj * HALF) = w;
                    const unsigned ww[4] = {w.x, w.y, w.z, w.w};
#pragma unroll
                    for (int k = 0; k < 4; ++k) { const float a = bf2f(ww[k]), b = bf2f(ww[k] >> 16); s += a + b; q += a * a + b * b; } }
                s += __shfl_xor(s, 16); s += __shfl_xor(s, 32); q += __shfl_xor(q, 16); q += __shfl_xor(q, 32);
                if (fq == 0) PS[(size_t)r * 16 + u.pn * 4 + wc] = make_float2(s, q); }
    }
};
struct EpiLogits {
    static constexpr bool PERM = true;
    float* LG;
    __device__ __forceinline__ void operator()(const f32x4 (&acc)[2][2][4][2], const Unit& u, int wr, int wc, int fr, int fq) const {
        if (wc >= 2) return;
        const int row0 = u.pm * BM + wr * 64 + fr, col0 = wc * 32 + 8 * fq;
#pragma unroll
        for (int ai = 0; ai < 2; ++ai)
#pragma unroll
            for (int m = 0; m < 4; ++m) { float* p = LG + (size_t)(row0 + ai * HALF + m * 16) * 64 + col0; *(f32x4*)p = acc[ai][0][m][0]; *(f32x4*)(p + 4) = acc[ai][0][m][1]; }
    }
};
struct EpiGU {
    static constexpr bool PERM = true;
    const float4* SLOT; const float* SGU; const float* TGU; bf16_t* HID;
    __device__ __forceinline__ void operator()(const f32x4 (&acc)[2][2][4][2], const Unit& u, int wr, int wc, int fr, int fq) const {
        const int e = u.e, j = u.pn & 1, fcol = wc * 32 + 8 * fq;
        const float* sgp = SGU + e * 512 + 256 * j + fcol; const float* tgp = TGU + e * 512 + 256 * j + fcol;
        const f32x4 sg0 = *(const f32x4*)(sgp), sg1 = *(const f32x4*)(sgp + 4), su0 = *(const f32x4*)(sgp + 128), su1 = *(const f32x4*)(sgp + 132);
        const f32x4 tg0 = *(const f32x4*)(tgp), tg1 = *(const f32x4*)(tgp + 4), tu0 = *(const f32x4*)(tgp + 128), tu1 = *(const f32x4*)(tgp + 132);
#pragma unroll
        for (int ai = 0; ai < 2; ++ai)
#pragma unroll
            for (int m = 0; m < 4; ++m) { const int rl = ai * HALF + wr * 64 + m * 16 + fr;
                const float4 si = SLOT[(size_t)e * T + u.tl * BM + rl]; const float rstd = si.y, rm = si.y * si.z, cw = si.w;
                float h[8];
#pragma unroll
                for (int n = 0; n < 2; ++n) { const f32x4 ag = acc[ai][0][m][n], au = acc[ai][1][m][n]; const f32x4 sg = n ? sg1 : sg0, su = n ? su1 : su0, tg = n ? tg1 : tg0, tu = n ? tu1 : tu0;
#pragma unroll
                    for (int k = 0; k < 4; ++k) { const float g = rstd * ag[k] - rm * sg[k] + tg[k], uu = rstd * au[k] - rm * su[k] + tu[k];
                        h[4 * n + k] = g * __builtin_amdgcn_rcpf(1.f + __expf(-g)) * uu * cw; } }
                u32x4 w; w.x = cvt_pk_bf16(h[0], h[1]); w.y = cvt_pk_bf16(h[2], h[3]); w.z = cvt_pk_bf16(h[4], h[5]); w.w = cvt_pk_bf16(h[6], h[7]);
                *(u32x4*)(HID + (size_t)(u.pm * BM + rl) * DE + 128 * j + fcol) = w; }
    }
};

template <class Epi, class Sched, class ASrc, bool ALIGN_EPI>
__device__ __forceinline__ void gemm_phase(LAS unsigned char* lds, const bf16_t* Ag, const bf16_t* Btg, const int K, const Sched& S, const Epi& E, const ASrc& AS) {
    const int tid = threadIdx.x, wid = __builtin_amdgcn_readfirstlane(tid >> 6), lane = tid & 63, wr = wid >> 2, wc = wid & 3, fr = lane & 15, fq = lane >> 4;
    const int nt = K / BK;
    unsigned voffA[2], voffB[2]; int RA[2], CA[2];
#pragma unroll
    for (int i = 0; i < 2; ++i) { int R, C; stage_rc(tid * 16 + i * 8192, R, C); const int Rb = Epi::PERM ? ((R & ~31) + perm32(R & 31)) : R; RA[i] = R; CA[i] = C;
        voffA[i] = (unsigned)(R * K + C) * 2u; voffB[i] = (unsigned)(Rb * K + C) * 2u; }
    const size_t kstep = (size_t)(BK * 2);
    const size_t hstep = (size_t)HALF * K * 2;
    const size_t tstep = 2 * hstep;
    const unsigned ldsw = (unsigned)wid * 1024u;
    const int aoff = lds_byte(wr * 64 + fr, fq * 8), boff = lds_byte(wc * 32 + fr, fq * 8);
#define PG8_SA(b, h) (((b) * 2 + (h)) * HTB)
#define PG8_SB(b, h) ((4 + (b) * 2 + (h)) * HTB)
#define PG8_STAGE(bufoff, gbase, voff) do { _Pragma("unroll") for (int _i = 0; _i < 2; ++_i) \
        __builtin_amdgcn_global_load_lds((const unsigned*)((const char*)(gbase) + (voff)[_i]), (LAS unsigned*)(lds + (bufoff) + ldsw + _i * 8192), 16, 0, 0); } while (0)
#define PG8_LDA(dst, b, h) do { _Pragma("unroll") for (int m = 0; m < 4; ++m) _Pragma("unroll") for (int k = 0; k < 2; ++k) dst[m][k] = *(const LAS bf16x8*)(lds + PG8_SA(b, h) + aoff + m * 2048 + k * 1024); } while (0)
#define PG8_LDB(dst, b, h) do { _Pragma("unroll") for (int n = 0; n < 2; ++n) _Pragma("unroll") for (int k = 0; k < 2; ++k) dst[n][k] = *(const LAS bf16x8*)(lds + PG8_SB(b, h) + boff + n * 2048 + k * 1024); } while (0)
#define PG8_MMA(ai, bj, At, Bt) do { __builtin_amdgcn_s_setprio(1); _Pragma("unroll") for (int m = 0; m < 4; ++m) _Pragma("unroll") for (int n = 0; n < 2; ++n) _Pragma("unroll") for (int k = 0; k < 2; ++k) \
        acc[ai][bj][m][n] = __builtin_amdgcn_mfma_f32_16x16x32_bf16(Bt[n][k], At[m][k], acc[ai][bj][m][n], 0, 0, 0); __builtin_amdgcn_s_setprio(0); } while (0)
#define PG8_WAIT_V(n) asm volatile("s_waitcnt vmcnt(" #n ")" ::: "memory")
#define PG8_WAIT_L(n) asm volatile("s_waitcnt lgkmcnt(" #n ")" ::: "memory")
#define PG8_BAR __builtin_amdgcn_s_barrier()
#define PG8_SCHED __builtin_amdgcn_sched_barrier(0)
#define PG8_GOFF(dst, uidx) do { if constexpr (ASrc::GATHER) { _Pragma("unroll") for (int _h = 0; _h < 2; ++_h) _Pragma("unroll") for (int _i = 0; _i < 2; ++_i) \
        dst[_h][_i] = (unsigned)(AS.toks[(uidx) * BM + _h * HALF + RA[_i]] * K + CA[_i]) * 2u; } } while (0)
#define PG8_AVO(h, nextc) (ASrc::GATHER ? ((nextc) ? nvo[h] : cvo[h]) : voffA)
    Unit cur, nxt; int ui = 0;
    if (!S.next(0, cur)) return;
    f32x4 acc[2][2][4][2];
#pragma unroll
    for (int a = 0; a < 2; ++a)
#pragma unroll
        for (int b = 0; b < 2; ++b)
#pragma unroll
            for (int m = 0; m < 4; ++m)
#pragma unroll
                for (int n = 0; n < 2; ++n) acc[a][b][m][n] = (f32x4){0.f, 0.f, 0.f, 0.f};
    bf16x8 At[4][2], B0[2][2], B1[2][2];
    unsigned cvo[2][2], nvo[2][2];
    if constexpr (ASrc::GATHER) { PG8_GOFF(cvo, 0);
#pragma unroll
        for (int h = 0; h < 2; ++h) { nvo[h][0] = cvo[h][0]; nvo[h][1] = cvo[h][1]; } }
    const char* cA0 = ASrc::GATHER ? (const char*)Ag : (const char*)Ag + (size_t)cur.pm * tstep; const char* cA1 = ASrc::GATHER ? cA0 : cA0 + hstep;
    const char* cB = (const char*)Btg + (size_t)cur.pn * tstep;
    PG8_STAGE(PG8_SB(0, 0), cB, voffB); PG8_STAGE(PG8_SB(0, 1), cB + hstep, voffB); PG8_STAGE(PG8_SA(0, 0), cA0, PG8_AVO(0, false)); PG8_STAGE(PG8_SA(0, 1), cA1, PG8_AVO(1, false));
    if (wr == 1) PG8_BAR;
    PG8_WAIT_V(2); PG8_BAR;
    PG8_STAGE(PG8_SB(1, 0), cB + kstep, voffB); PG8_STAGE(PG8_SA(1, 0), cA0 + kstep, PG8_AVO(0, false)); PG8_STAGE(PG8_SB(1, 1), cB + hstep + kstep, voffB);
    PG8_WAIT_V(6); PG8_BAR;
#define PG8_KBODY() do { \
            const bool last = (t == nt - 2); \
            const char* a1_1 = cA1 + (size_t)(t + 1) * kstep; \
            const char* a2_0 = last ? nA0 : cA0 + (size_t)(t + 2) * kstep; const char* a2_1 = last ? nA1 : cA1 + (size_t)(t + 2) * kstep; \
            const char* b2 = last ? nB : cB + (size_t)(t + 2) * kstep; const char* a3_0 = a2_0 + kstep; const char* b3 = b2 + kstep; \
            unsigned vs[2][2]; if constexpr (ASrc::GATHER) { _Pragma("unroll") for (int _h = 0; _h < 2; ++_h) _Pragma("unroll") for (int _i = 0; _i < 2; ++_i) vs[_h][_i] = last ? nvo[_h][_i] : cvo[_h][_i]; } \
            PG8_LDB(B0, 0, 0); PG8_LDB(B1, 0, 1); PG8_SCHED; PG8_LDA(At, 0, 0); PG8_STAGE(PG8_SA(1, 1), a1_1, PG8_AVO(1, false)); \
            PG8_WAIT_V(8); PG8_WAIT_L(0); PG8_BAR; PG8_MMA(0, 0, At, B0); PG8_MMA(0, 1, At, B1); PG8_BAR; PG8_SCHED; \
            PG8_LDA(At, 0, 1); PG8_STAGE(PG8_SB(0, 0), b2, voffB); PG8_STAGE(PG8_SB(0, 1), b2 + hstep, voffB); PG8_STAGE(PG8_SA(0, 0), a2_0, (ASrc::GATHER ? vs[0] : voffA)); \
            PG8_WAIT_V(8); PG8_WAIT_L(0); PG8_BAR; PG8_MMA(1, 0, At, B0); PG8_MMA(1, 1, At, B1); PG8_BAR; PG8_SCHED; \
            PG8_LDB(B0, 1, 0); PG8_LDB(B1, 1, 1); PG8_SCHED; PG8_LDA(At, 1, 0); PG8_STAGE(PG8_SA(0, 1), a2_1, (ASrc::GATHER ? vs[1] : voffA)); \
            PG8_WAIT_V(8); PG8_WAIT_L(0); PG8_BAR; PG8_MMA(0, 0, At, B0); PG8_MMA(0, 1, At, B1); PG8_BAR; PG8_SCHED; \
            PG8_LDA(At, 1, 1); PG8_STAGE(PG8_SB(1, 0), b3, voffB); PG8_STAGE(PG8_SB(1, 1), b3 + hstep, voffB); PG8_STAGE(PG8_SA(1, 0), a3_0, (ASrc::GATHER ? vs[0] : voffA)); \
            PG8_WAIT_V(8); PG8_WAIT_L(0); PG8_BAR; PG8_MMA(1, 0, At, B0); PG8_MMA(1, 1, At, B1); PG8_BAR; PG8_SCHED; } while (0)
    for (;;) {
        const bool has_next = S.next(ui + 1, nxt);
        const char* nA0 = cA0; const char* nA1 = cA1; const char* nB = cB;
        if (has_next) { nA0 = ASrc::GATHER ? (const char*)Ag : (const char*)Ag + (size_t)nxt.pm * tstep; nA1 = ASrc::GATHER ? nA0 : nA0 + hstep; nB = (const char*)Btg + (size_t)nxt.pn * tstep;
            if constexpr (ASrc::GATHER) { PG8_GOFF(nvo, ui + 1); } }
#pragma nounroll
        for (int t = 0; t < nt; t += 2) PG8_KBODY();
        if constexpr (ALIGN_EPI) { if (wr == 0) PG8_BAR; }
        E(acc, cur, wr, wc, fr, fq);
        if (!has_next) break;
#pragma unroll
        for (int a = 0; a < 2; ++a)
#pragma unroll
            for (int b = 0; b < 2; ++b)
#pragma unroll
                for (int m = 0; m < 4; ++m)
#pragma unroll
                    for (int n = 0; n < 2; ++n) acc[a][b][m][n] = (f32x4){0.f, 0.f, 0.f, 0.f};
        cur = nxt; cA0 = nA0; cA1 = nA1; cB = nB; ++ui;
        if constexpr (ASrc::GATHER) {
#pragma unroll
            for (int h = 0; h < 2; ++h) { cvo[h][0] = nvo[h][0]; cvo[h][1] = nvo[h][1]; } }
        if constexpr (ALIGN_EPI) { if (wr == 1) PG8_BAR; }
    }
    PG8_WAIT_V(0);
    if constexpr (!ALIGN_EPI) { if (wr == 0) PG8_BAR; }
    PG8_BAR;
#undef PG8_KBODY
#undef PG8_GOFF
#undef PG8_AVO
#undef PG8_SA
#undef PG8_SB
#undef PG8_STAGE
#undef PG8_LDA
#undef PG8_LDB
#undef PG8_MMA
#undef PG8_WAIT_V
#undef PG8_WAIT_L
#undef PG8_BAR
#undef PG8_SCHED
}
}

constexpr int NWAVES = 8;
constexpr int RING_OFF = 0, RING_BYTES = 131072;
constexpr int LDSCTL_OFF = RING_BYTES, MISC_OFF = LDSCTL_OFF + 320;
constexpr int LDS_BYTES = 147456;
constexpr int NPHASE = 8;
constexpr int CW_CNT = 0;
constexpr int CW_BAR = 4096;

#define XB_TMO      128
#define XB_XCNT(j)  (256  + 64 * (j))
#define XB_XSUB(j)  (1280 + 64 * (j))
#define XB_XGEN(j)  (2304 + 64 * (j))
#define XB_TOP      3328
#define XB_TOPGEN   3392
#define XCD_BAR_WORDS 3456
#define XB_SPIN_CAP (1u << 18)
__device__ __forceinline__ unsigned xb_ld(unsigned* p)              { return __hip_atomic_load(p, __ATOMIC_RELAXED, __HIP_MEMORY_SCOPE_AGENT); }
__device__ __forceinline__ unsigned xb_add(unsigned* p, unsigned v) { return __hip_atomic_fetch_add(p, v, __ATOMIC_RELAXED, __HIP_MEMORY_SCOPE_AGENT); }
__device__ __forceinline__ unsigned xb_xcc_id() { return (unsigned)__builtin_amdgcn_s_getreg((3 << 11) | 20) & 0xFu; }
#define XB_SPIN(cond, bar) do { unsigned _sp = 0; while (cond) { __builtin_amdgcn_s_sleep(1); \
    if ((++_sp & 255u) == 0u) { if (xb_ld(&(bar)[XB_TMO])) break; if (_sp > XB_SPIN_CAP) { atomicAdd(&(bar)[XB_TMO], 1u); break; } } } } while (0)
struct XcdBarrier { unsigned* bar; unsigned x; volatile LAS unsigned* st; };
__device__ __forceinline__ XcdBarrier xcd_barrier_post(unsigned* bar, volatile LAS unsigned* st) {
    XcdBarrier b; b.bar = bar; b.x = xb_xcc_id(); b.st = st;
    if (threadIdx.x == 0) (void)xb_add(&bar[XB_XCNT(b.x)], 1u);
    return b;
}
__device__ __forceinline__ void xcd_barrier_complete(unsigned* bar, unsigned x, unsigned& nloc, unsigned& nx) {
    const unsigned G = gridDim.x * gridDim.y * gridDim.z;
    unsigned sum, cnt, mine, sp = 0u;
    for (;;) {
        sum = 0u; cnt = 0u; mine = 0u;
#pragma unroll
        for (unsigned j = 0; j < 16; ++j) { const unsigned c = xb_ld(&bar[XB_XCNT(j)]); sum += c; cnt += (c > 0u) ? 1u : 0u; mine = (j == x) ? c : mine; }
        if (sum == G) break;
        __builtin_amdgcn_s_sleep(1);
        if ((++sp & 255u) == 0u) { if (xb_ld(&bar[XB_TMO])) break; if (sp > XB_SPIN_CAP) { atomicAdd(&bar[XB_TMO], 1u); break; } }
    }
    nloc = mine > 0u ? mine : 1u; nx = cnt > 0u ? cnt : 1u;
}
__device__ __forceinline__ void xcd_barrier(const XcdBarrier& b) {
    asm volatile("s_waitcnt vmcnt(0)" ::: "memory");
    __syncthreads();
    if (threadIdx.x == 0) {
        unsigned* bar = b.bar;
        __builtin_amdgcn_s_waitcnt(0);
        unsigned nloc = b.st[0], nx = b.st[1];
        if (nloc == 0u) { xcd_barrier_complete(bar, b.x, nloc, nx); b.st[0] = nloc; b.st[1] = nx; }
        const unsigned old = xb_add(&bar[XB_XSUB(b.x)], 1u);
        const unsigned gen = old / nloc;
        if (old + 1u == (gen + 1u) * nloc) {
            __builtin_amdgcn_fence(__ATOMIC_RELEASE, "agent");
            asm volatile("s_waitcnt vmcnt(0)" ::: "memory");
            const unsigned og = xb_add(&bar[XB_TOP], 1u);
            const unsigned tg = og / nx;
            if (og + 1u == (tg + 1u) * nx) xb_add(&bar[XB_TOPGEN], 1u);
            else XB_SPIN(xb_ld(&bar[XB_TOPGEN]) == tg, bar);
            __builtin_amdgcn_fence(__ATOMIC_ACQUIRE, "agent");
            xb_add(&bar[XB_XGEN(b.x)], 1u);
            asm volatile("s_waitcnt vmcnt(0)" ::: "memory");
        } else {
            XB_SPIN(xb_ld(&bar[XB_XGEN(b.x)]) == gen, bar);
            __builtin_amdgcn_fence(__ATOMIC_ACQUIRE, "agent");
            asm volatile("s_waitcnt vmcnt(0)" ::: "memory");
        }
    }
    __syncthreads();
}

struct Args { const float* in[22]; float* out; unsigned char* ws; int ph_lo, ph_hi, li, pad; };


#define LDS_WAIT() asm volatile("s_waitcnt lgkmcnt(0)" ::: "memory")
#define VM_WAIT() asm volatile("s_waitcnt vmcnt(0)" ::: "memory")
__device__ __forceinline__ unsigned pk2(float lo, float hi) { return f2bf(lo) | (f2bf(hi) << 16); }
__device__ __forceinline__ float wave_sum(float v) {
#pragma unroll
    for (int o = 1; o < 64; o <<= 1) v += __shfl_xor(v, o);
    return v;
}
__device__ __forceinline__ void p0_transpose_item(const float* __restrict__ W, int K, int N, bf16_t* __restrict__ WT, const float* __restrict__ scale, int blk, int stride, int off, LAS float* scr, int item, int lane) {
    const int nblk = N / 32, kb = item / nblk, nb = item % nblk, k0 = 64 * kb, n0 = 32 * nb;
#pragma unroll 8
    for (int i = 0; i < 32; ++i) { const int kk = 2 * i + (lane >> 5); float w = W[(size_t)(k0 + kk) * N + n0 + (lane & 31)]; if (scale) w *= scale[k0 + kk]; scr[kk * 33 + (lane & 31)] = w; }
    LDS_WAIT();
    const int c = lane & 7;
#pragma unroll
    for (int j = 0; j < 4; ++j) { const int n = (lane >> 3) + 8 * j; const LAS float* sp = scr + (8 * c) * 33 + n;
        u32x4 o; o.x = pk2(sp[0 * 33], sp[1 * 33]); o.y = pk2(sp[2 * 33], sp[3 * 33]); o.z = pk2(sp[4 * 33], sp[5 * 33]); o.w = pk2(sp[6 * 33], sp[7 * 33]);
        const int nn = n0 + n, dr = (nn / blk) * stride + off + nn % blk;
        *(u32x4*)(WT + (size_t)dr * K + k0 + 8 * c) = o; }
    LDS_WAIT();
}
__device__ __forceinline__ void p0_prologue(const Args& args, unsigned char* ws, LAS unsigned char* lds, int G) {
    const int tid = threadIdx.x, lane = tid & 63, wave = __builtin_amdgcn_readfirstlane(tid >> 6);
    const float* x = args.in[0]; const float* w_in = args.in[1]; const float* lam = args.in[8]; const float* w_out = args.in[10]; const float* g1 = args.in[11]; const float* b1 = args.in[12];
    const float* rgw = args.in[13]; const float* rgb = args.in[14]; const float* rew = args.in[15]; const float* reb = args.in[16];
    const float* wg = args.in[17]; const float* wu = args.in[18]; const float* wd = args.in[19];
    float* vec = (float*)(ws + WS_VEC);
    bf16_t* WIN = (bf16_t*)(ws + WS_WIN); bf16_t* WOUT = (bf16_t*)(ws + WS_WOUT); bf16_t* WR = (bf16_t*)(ws + WS_WR); bf16_t* WGU = (bf16_t*)(ws + WS_WGU); bf16_t* WD = (bf16_t*)(ws + WS_WD);
    bf16_t* XB = (bf16_t*)(ws + WS_XB);
    LAS float* scr = (LAS float*)(lds + wave * 16384);
    const int gw = (int)blockIdx.x * NWAVES + wave, NGW = G * NWAVES;
    const size_t gtid = (size_t)blockIdx.x * (NWAVES * 64) + tid, NT = (size_t)G * NWAVES * 64;
    constexpr int I_IN = (D / 64) * (NPROJ / 32), I_OUT = (D / 64) * (D / 32), I_RE = (D / 64), I_G = (D / 64) * (DE / 32), I_D = (DE / 64) * (D / 32);
    constexpr int NITEMS = I_IN + I_OUT + I_RE + NE * (2 * I_G + I_D);
    for (int it = gw; it < NITEMS; it += NGW) {
        int r = it;
        if (r < I_IN) { p0_transpose_item(w_in, D, NPROJ, WIN, nullptr, NPROJ, 0, 0, scr, r, lane); continue; } r -= I_IN;
        if (r < I_OUT) { p0_transpose_item(w_out, D, D, WOUT, nullptr, D, 0, 0, scr, r, lane); continue; } r -= I_OUT;
        if (r < I_RE) { p0_transpose_item(rew, D, 32, WR, g1, 32, 0, 4, scr, r, lane); continue; } r -= I_RE;
        if (r < NE * I_G) { const int e = r / I_G; p0_transpose_item(wg + (size_t)e * D * DE, D, DE, WGU + (size_t)e * 512 * D, g1, 128, 256, 0, scr, r % I_G, lane); continue; } r -= NE * I_G;
        if (r < NE * I_G) { const int e = r / I_G; p0_transpose_item(wu + (size_t)e * D * DE, D, DE, WGU + (size_t)e * 512 * D, g1, 128, 256, 128, scr, r % I_G, lane); continue; } r -= NE * I_G;
        { const int e = r / I_D; p0_transpose_item(wd + (size_t)e * DE * D, DE, D, WD + (size_t)e * D * DE, nullptr, D, 0, 0, scr, r % I_D, lane); }
    }
    for (size_t i = gtid; i < (size_t)4 * D; i += NT) { const int n = (int)(i / D), k = (int)(i % D); WR[(size_t)n * D + k] = (bf16_t)f2bf(g1[k] * rgw[k * 4 + n]); }
    for (size_t i = gtid; i < (size_t)220 * D / 8; i += NT) ((u32x4*)(WR + 36 * D))[i] = (u32x4){0u, 0u, 0u, 0u};
    if (gw % 7 == 0 && gw / 7 < 257) {
        const int it = gw / 7;
        if (it < 256) { const int e = it >> 3, cb = it & 7, n = (cb & 3) * 64 + lane; const float* W = (cb < 4 ? wg : wu) + (size_t)e * D * DE + n;
            float sa = 0.f, ta = 0.f;
#pragma unroll 8
            for (int k = 0; k < D; ++k) { const float w = W[(size_t)k * DE]; sa += g1[k] * w; ta += b1[k] * w; }
            const int dr = (n / 128) * 256 + (cb < 4 ? 0 : 128) + n % 128; vec[V_SGU + e * 512 + dr] = sa; vec[V_TGU + e * 512 + dr] = ta;
        } else if (lane < 36) {
            float sa = 0.f, ta = 0.f;
            for (int k = 0; k < D; ++k) { const float w = lane < 4 ? rgw[k * 4 + lane] : rew[k * 32 + lane - 4]; sa += g1[k] * w; ta += b1[k] * w; }
            vec[V_SR + lane] = sa; vec[V_TR + lane] = ta + (lane < 4 ? rgb[lane] : reb[lane - 4]);
        }
    }
    if (gtid < DRG) vec[V_SP + gtid] = 8.0f * log1pf(expf(-lam[gtid]));
    for (size_t i = gtid; i < (size_t)T * D / 8; i += NT) { const f32x4 a = ((const f32x4*)x)[2 * i], b = ((const f32x4*)x)[2 * i + 1];
        u32x4 o; o.x = pk2(a.x, a.y); o.y = pk2(a.z, a.w); o.z = pk2(b.x, b.y); o.w = pk2(b.z, b.w); ((u32x4*)XB)[i] = o; }
}
__device__ __forceinline__ void p2_mixer_simple(const Args& args, unsigned char* ws, LAS unsigned char* lds, int G) {
    const int tid = threadIdx.x, lane = tid & 63, wave = __builtin_amdgcn_readfirstlane(tid >> 6);
    const float* cw = args.in[2]; const float* cb = args.in[3]; const float* Wa = args.in[4]; const float* ba = args.in[5]; const float* Wx = args.in[6]; const float* bx = args.in[7]; const float* scw = args.in[9];
    const float* sp = (const float*)(ws + WS_VEC) + V_SP;
    const bf16_t* PROJ = (const bf16_t*)(ws + WS_PROJ); bf16_t* Y = (bf16_t*)(ws + WS_Y);
    if (wave == 0) {
        LAS float* wa = (LAS float*)lds; LAS float* wx = wa + 4096; LAS float* xs = wx + 4096;
        for (int item = blockIdx.x; item < NBATCH * 8; item += G) {
            const int b = item >> 3, h = item & 7, c = h * 64 + lane;
            for (int i = 0; i < 64; ++i) { wa[i * 64 + lane] = Wa[(h * 64 + i) * 64 + lane]; wx[i * 64 + lane] = Wx[(h * 64 + i) * 64 + lane]; }
            const float w0 = cw[0 * DRG + c], w1 = cw[1 * DRG + c], w2 = cw[2 * DRG + c], w3 = cw[3 * DRG + c], cbias = cb[c], bac = ba[c], bxc = bx[c], spc = sp[c];
            float x0 = 0.f, x1 = 0.f, x2 = 0.f, hs = 0.f;
            LDS_WAIT();
            for (int t = 0; t < SEQ; ++t) {
                const size_t row = (size_t)b * SEQ + t;
                const float x3 = bf2f(PROJ[row * NPROJ + c]);
                const float xc = cbias + w0 * x0 + w1 * x1 + w2 * x2 + w3 * x3;
                x0 = x1; x1 = x2; x2 = x3;
                xs[lane] = xc;
                LDS_WAIT();
                float ra = bac, rx = bxc;
#pragma unroll 8
                for (int i = 0; i < 64; ++i) { const float v = xs[i]; ra += v * wa[i * 64 + lane]; rx += v * wx[i * 64 + lane]; }
                const float r = sigmoidf_(ra), ii = sigmoidf_(rx);
                const float la = -spc * r, a = __expf(la), mult = sqrtf(fmaxf(1.f - a * a, 0.f));
                hs = a * hs + mult * (ii * xc);
                const float gate = bf2f(PROJ[row * NPROJ + DRG + c]);
                Y[row * D + c] = (bf16_t)f2bf(hs * gelu_tanh(gate));
                LDS_WAIT();
            }
        }
    }
    const size_t gtid = (size_t)blockIdx.x * (NWAVES * 64) + tid, NT = (size_t)G * NWAVES * 64;
    for (size_t i = gtid; i < (size_t)T * DRG; i += NT) {
        const int c = (int)(i % DRG); const size_t row = i / DRG; const int t = (int)(row % SEQ);
        float s = 0.f;
#pragma unroll
        for (int k = 0; k < 3; ++k) { const int tt = t - 2 + k; if (tt >= 0) { const size_t r2 = row - 2 + k; s += scw[k * DRG + c] * (bf2f(PROJ[r2 * NPROJ + 1536 + c]) * bf2f(PROJ[r2 * NPROJ + 2048 + c])); } }
        Y[row * D + DRG + c] = (bf16_t)f2bf(bf2f(PROJ[row * NPROJ + 1024 + c]) * s);
    }
}
__device__ __forceinline__ void p4_route_tile(int pm, const float* __restrict__ LG, const float2* __restrict__ PS, const float* __restrict__ SR, const float* __restrict__ TR,
                                              unsigned* cnt, float4* __restrict__ SLOT, int* __restrict__ TOKSLOT, volatile LAS unsigned* MISC) {
    const int tid = threadIdx.x;
    LAS unsigned* hist = (LAS unsigned*)(MISC + 96); LAS unsigned* gbase = (LAS unsigned*)(MISC + 128);
    if (tid < 32) hist[tid] = 0u;
    __syncthreads();
    int ea = 0, eb = 0; unsigned ra = 0, rb = 0; float w1 = 0.f, w2 = 0.f, mu = 0.f, rstd = 0.f; const int t = pm * 256 + tid;
    if (tid < 256) {
        float s = 0.f, q = 0.f;
#pragma unroll
        for (int j = 0; j < 8; ++j) { const f32x4 a = *(const f32x4*)((const float*)(PS + (size_t)t * 16) + 4 * j); s += a.x + a.z; q += a.y + a.w; }
        mu = s * (1.f / D); rstd = 1.f / sqrtf(fmaxf(q * (1.f / D) - mu * mu, 0.f) + LN_EPS);
        float lg[36];
#pragma unroll
        for (int j = 0; j < 9; ++j) { const f32x4 a = *(const f32x4*)(LG + (size_t)t * 64 + 4 * j); lg[4 * j] = a.x; lg[4 * j + 1] = a.y; lg[4 * j + 2] = a.z; lg[4 * j + 3] = a.w; }
#pragma unroll
        for (int j = 0; j < 36; ++j) lg[j] = rstd * (lg[j] - mu * SR[j]) + TR[j];
        int g = 0; float gm = lg[0];
#pragma unroll
        for (int j = 1; j < NGRP; ++j) if (lg[j] > gm) { gm = lg[j]; g = j; }
        float den = 0.f;
#pragma unroll
        for (int j = 0; j < NGRP; ++j) den += __expf(lg[j] - gm);
        const float gp = 1.f / den;
        float el[EPG];
#pragma unroll
        for (int j = 0; j < EPG; ++j) el[j] = g == 0 ? lg[4 + j] : g == 1 ? lg[12 + j] : g == 2 ? lg[20 + j] : lg[28 + j];
        int i1 = 0; float v1 = el[0];
#pragma unroll
        for (int j = 1; j < EPG; ++j) if (el[j] > v1) { v1 = el[j]; i1 = j; }
        int i2 = 0; float v2 = -INFINITY;
#pragma unroll
        for (int j = 0; j < EPG; ++j) if (j != i1 && el[j] > v2) { v2 = el[j]; i2 = j; }
        const float e2 = __expf(v2 - v1); w1 = gp / (1.f + e2); w2 = gp * e2 / (1.f + e2);
        ea = g * EPG + i1; eb = g * EPG + i2;
        ra = __hip_atomic_fetch_add(&hist[ea], 1u, __ATOMIC_RELAXED, __HIP_MEMORY_SCOPE_WORKGROUP); rb = __hip_atomic_fetch_add(&hist[eb], 1u, __ATOMIC_RELAXED, __HIP_MEMORY_SCOPE_WORKGROUP);
    }
    __syncthreads();
    if (tid < 32) gbase[tid] = hist[tid] ? __hip_atomic_fetch_add(cnt + tid, hist[tid], __ATOMIC_RELAXED, __HIP_MEMORY_SCOPE_AGENT) : 0u;
    __syncthreads();
    if (tid < 256) {
        const int pa = (int)(gbase[ea] + ra), pb = (int)(gbase[eb] + rb);
        SLOT[(size_t)ea * T + pa] = make_float4(__builtin_bit_cast(float, t), rstd, mu, w1);
        SLOT[(size_t)eb * T + pb] = make_float4(__builtin_bit_cast(float, t), rstd, mu, w2);
        TOKSLOT[t * 2 + 0] = ea * T + pa; TOKSLOT[t * 2 + 1] = eb * T + pb;
    }
    __syncthreads();
}
__device__ __forceinline__ void p7_final(const Args& args, unsigned char* ws, const LAS int* pref, int G) {
    const int tid = threadIdx.x, lane = tid & 63, wave = __builtin_amdgcn_readfirstlane(tid >> 6);
    const float* g1 = args.in[11]; const float* b1 = args.in[12]; const float* g2 = args.in[20]; const float* b2 = args.in[21];
    const bf16_t* Z = (const bf16_t*)(ws + WS_Z); const bf16_t* C = (const bf16_t*)(ws + WS_PROJ); const float2* PS = (const float2*)(ws + WS_PSTATS); const int* TOKSLOT = (const int*)(ws + WS_TOKSLOT);
    float* out = args.out;
    f32x4 G1[4], B1[4], G2[4], B2[4];
#pragma unroll
    for (int j = 0; j < 4; ++j) { const int c = 4 * lane + 256 * j; G1[j] = *(const f32x4*)(g1 + c); B1[j] = *(const f32x4*)(b1 + c); G2[j] = *(const f32x4*)(g2 + c); B2[j] = *(const f32x4*)(b2 + c); }
    for (int t = (int)blockIdx.x * NWAVES + wave; t < T; t += G * NWAVES) {
        const float2 ps = PS[(size_t)t * 16 + (lane & 15)];
        float s = ps.x, q = ps.y;
#pragma unroll
        for (int o = 1; o < 16; o <<= 1) { s += __shfl_xor(s, o); q += __shfl_xor(q, o); }
        const float mu = s * (1.f / D), rstd = 1.f / sqrtf(fmaxf(q * (1.f / D) - mu * mu, 0.f) + LN_EPS);
        const int s1 = TOKSLOT[t * 2], s2 = TOKSLOT[t * 2 + 1];
        const size_t r1 = (size_t)pref[s1 >> 15] * 256 + (s1 & (T - 1)), r2 = (size_t)pref[s2 >> 15] * 256 + (s2 & (T - 1));
        f32x4 v[4]; float sum = 0.f;
#pragma unroll
        for (int j = 0; j < 4; ++j) { const int c = 4 * lane + 256 * j;
            const uint2 zz = *(const uint2*)(Z + (size_t)t * D + c), c1 = *(const uint2*)(C + r1 * D + c), c2 = *(const uint2*)(C + r2 * D + c);
            f32x4 zf = {bf2f(zz.x), bf2f(zz.x >> 16), bf2f(zz.y), bf2f(zz.y >> 16)};
            f32x4 cf = {bf2f(c1.x) + bf2f(c2.x), bf2f(c1.x >> 16) + bf2f(c2.x >> 16), bf2f(c1.y) + bf2f(c2.y), bf2f(c1.y >> 16) + bf2f(c2.y >> 16)};
            v[j] = ALPHA * ((zf - mu) * rstd * G1[j] + B1[j]) + cf; sum += (v[j].x + v[j].y) + (v[j].z + v[j].w); }
        const float m2 = wave_sum(sum) * (1.f / D); float qq = 0.f;
#pragma unroll
        for (int j = 0; j < 4; ++j) { v[j] = v[j] - m2; qq += (v[j].x * v[j].x + v[j].y * v[j].y) + (v[j].z * v[j].z + v[j].w * v[j].w); }
        const float r2s = 1.f / sqrtf(wave_sum(qq) * (1.f / D) + LN_EPS);
#pragma unroll
        for (int j = 0; j < 4; ++j) *(f32x4*)(out + (size_t)t * D + 4 * lane + 256 * j) = v[j] * r2s * G2[j] + B2[j];
    }
}

__global__ void __launch_bounds__(NWAVES * 64, 2) mk_fwd(Args args) {
    extern __shared__ __attribute__((aligned(16))) unsigned char lds_raw[];
    LAS unsigned char* lds = (LAS unsigned char*)lds_raw;
    volatile LAS unsigned* MISC = (volatile LAS unsigned*)(lds + MISC_OFF);
    const int tid = threadIdx.x;
    const int G = gridDim.x;
    unsigned char* ws = args.ws;
    unsigned* ctl = (unsigned*)(ws + WS_CTL);
    float* vec = (float*)(ws + WS_VEC);
    bf16_t* WIN = (bf16_t*)(ws + WS_WIN); bf16_t* WOUT = (bf16_t*)(ws + WS_WOUT); bf16_t* WGU = (bf16_t*)(ws + WS_WGU); bf16_t* WD = (bf16_t*)(ws + WS_WD);
    bf16_t* XB = (bf16_t*)(ws + WS_XB); bf16_t* PROJ = (bf16_t*)(ws + WS_PROJ); bf16_t* CONTRIB = (bf16_t*)(ws + WS_PROJ);
    bf16_t* Y = (bf16_t*)(ws + WS_Y); bf16_t* Z = (bf16_t*)(ws + WS_Z); bf16_t* HID = (bf16_t*)(ws + WS_HID);
    float4* SLOT = (float4*)(ws + WS_SLOT); float2* PS = (float2*)(ws + WS_PSTATS);
    for (int u = tid; u < (LDS_BYTES - LDSCTL_OFF) / 4; u += NWAVES * 64) ((LAS unsigned*)(lds + LDSCTL_OFF))[u] = 0u;
    __syncthreads();
    XcdBarrier bar = xcd_barrier_post(ctl + CW_BAR + args.li * XCD_BAR_WORDS, MISC + 8);
    const int lo = args.ph_lo, hi = args.ph_hi;
#define IN(k) (lo <= (k) && (k) < hi)
#define BOTH(k) (IN(k) && IN((k) + 1))
#define GRID_BAR() xcd_barrier(bar)

    if (IN(0)) { p0_prologue(args, ws, lds, G); if (BOTH(0)) GRID_BAR(); }
    if (IN(1)) {
        pg8::StaticOrder S; S.init(T, NPROJ, G, (int)blockIdx.x);
        pg8::EpiBf16 E{PROJ, NPROJ, 0xffff};
        pg8::gemm_phase<pg8::EpiBf16, pg8::StaticOrder, pg8::DenseA, true>(lds + RING_OFF, XB, WIN, D, S, E, pg8::DenseA{});
        if (BOTH(1)) GRID_BAR();
    }
    if (IN(2)) { p2_mixer_simple(args, ws, lds, G); if (BOTH(2)) GRID_BAR(); }
    if (IN(3)) {
        pg8::StaticOrder S; S.init(T, D, G, (int)blockIdx.x);
        pg8::EpiZ E{XB, Z, PS};
        pg8::gemm_phase<pg8::EpiZ, pg8::StaticOrder, pg8::DenseA, true>(lds + RING_OFF, Y, WOUT, D, S, E, pg8::DenseA{});
        if (BOTH(3)) GRID_BAR();
    }
    if (IN(4)) {
        float* LG = (float*)(ws + WS_HID);
        pg8::StaticOrder S; S.init(T, 256, G, (int)blockIdx.x);
        pg8::EpiLogits E{LG};
        pg8::gemm_phase<pg8::EpiLogits, pg8::StaticOrder, pg8::DenseA, true>(lds + RING_OFF, Z, (const bf16_t*)(ws + WS_WR), D, S, E, pg8::DenseA{});
        pg8::Unit u;
        if (S.next(0, u)) {
            VM_WAIT(); __syncthreads();
            __builtin_amdgcn_fence(__ATOMIC_ACQUIRE, "agent"); VM_WAIT();
            p4_route_tile(u.pm, LG, PS, vec + V_SR, vec + V_TR, ctl + CW_CNT, SLOT, (int*)(ws + WS_TOKSLOT), MISC);
        }
        if (BOTH(4)) GRID_BAR();
    }
    if (IN(5) || IN(6) || IN(7)) {
        if (tid < 32) MISC[64 + tid] = ctl[CW_CNT + tid];
        __syncthreads();
        if (tid == 0) { int s = 0; for (int e = 0; e < NE; ++e) { MISC[16 + e] = (unsigned)s; s += ((int)MISC[64 + e] + 255) / 256; } MISC[16 + NE] = (unsigned)s; }
        __syncthreads();
        const LAS int* pref = (const LAS int*)(lds + MISC_OFF) + 16; const LAS int* cntl = (const LAS int*)(lds + MISC_OFF) + 64;
        const int ntiles = pref[NE];
        if (IN(5)) {
            pg8::MoeOrder S{pref, 2, ntiles * 2, G, (int)blockIdx.x};
            LAS int* toks = (LAS int*)(lds + MISC_OFF + 1024);
            { pg8::Unit u; for (int i = 0; i < 4 && S.next(i, u); ++i) { if (tid < 256) { const int pos = u.tl * 256 + tid; toks[i * 256 + tid] = pos < cntl[u.e] ? __builtin_bit_cast(int, SLOT[(size_t)u.e * T + pos].x) : 0; } } }
            __syncthreads();
            pg8::EpiGU E{SLOT, vec + V_SGU, vec + V_TGU, HID};
            pg8::GatherA AS{toks};
            pg8::gemm_phase<pg8::EpiGU, pg8::MoeOrder, pg8::GatherA, true>(lds + RING_OFF, Z, WGU, D, S, E, AS);
            if (BOTH(5)) GRID_BAR();
        }
        if (IN(6)) {
            pg8::MoeOrder S{pref, 4, ntiles * 4, G, (int)blockIdx.x};
            pg8::EpiBf16 E{CONTRIB, D, 3};
            pg8::gemm_phase<pg8::EpiBf16, pg8::MoeOrder, pg8::DenseA, true>(lds + RING_OFF, HID, WD, DE, S, E, pg8::DenseA{});
            if (BOTH(6)) GRID_BAR();
        }
        if (IN(7)) p7_final(args, ws, pref, G);
    }
#undef IN
#undef BOTH
#undef GRID_BAR
}

static int mk_grid() {
    static int grid = 0;
    if (grid == 0) {
        int dev = 0, cus = 0;
        if (hipGetDevice(&dev) != hipSuccess || hipDeviceGetAttribute(&cus, hipDeviceAttributeMultiprocessorCount, dev) != hipSuccess) { grid = -1; return grid; }
        if (hipFuncSetAttribute((const void*)mk_fwd, hipFuncAttributeMaxDynamicSharedMemorySize, LDS_BYTES) != hipSuccess) { grid = -1; return grid; }
        int per_cu = 0;
        if (hipOccupancyMaxActiveBlocksPerMultiprocessor(&per_cu, (const void*)mk_fwd, NWAVES * 64, LDS_BYTES) != hipSuccess || per_cu < 1) { (void)hipGetLastError(); grid = -1; return grid; }
        grid = cus;
    }
    return grid;
}
static int g_li = 0;
static void mk_launch(const Args& base, int lo, int hi, hipStream_t stream) {
    const int grid = mk_grid(); if (grid <= 0) return;
    Args a = base; a.ph_lo = lo; a.ph_hi = hi; a.li = g_li++;
    hipLaunchKernelGGL(mk_fwd, dim3(grid), dim3(NWAVES * 64), LDS_BYTES, stream, a);
}

extern "C" void kernel_launch(void* const* d_in, const int* in_sizes, int n_in, void* d_out, int out_size, void* d_ws, size_t ws_size, hipStream_t stream) {
    if (ws_size < WS_END || n_in != 22) return;
    const float* x = (const float*)d_in[0]; const float* w_in = (const float*)d_in[1]; const float* rg_cw = (const float*)d_in[2]; const float* rg_cb = (const float*)d_in[3];
    const float* Wa = (const float*)d_in[4]; const float* ba = (const float*)d_in[5]; const float* Wx = (const float*)d_in[6]; const float* bx = (const float*)d_in[7];
    const float* lam = (const float*)d_in[8]; const float* sc_cw = (const float*)d_in[9]; const float* w_out = (const float*)d_in[10]; const float* g1 = (const float*)d_in[11]; const float* b1 = (const float*)d_in[12];
    const float* rgw = (const float*)d_in[13]; const float* rgb = (const float*)d_in[14]; const float* rew = (const float*)d_in[15]; const float* reb = (const float*)d_in[16];
    const float* wg = (const float*)d_in[17]; const float* wu = (const float*)d_in[18]; const float* wd = (const float*)d_in[19]; const float* g2 = (const float*)d_in[20]; const float* b2 = (const float*)d_in[21];
    char* ws = (char*)d_ws;
    int* cnt = (int*)(ws + WS_CTL); float* vec = (float*)(ws + WS_VEC); int* base = (int*)(vec + V_BASE);
    bf16_t* WIN = (bf16_t*)(ws + WS_WIN); bf16_t* WOUT = (bf16_t*)(ws + WS_WOUT); bf16_t* WR = (bf16_t*)(ws + WS_WR); bf16_t* WGU = (bf16_t*)(ws + WS_WGU); bf16_t* WD = (bf16_t*)(ws + WS_WD);
    bf16_t* XB = (bf16_t*)(ws + WS_XB); bf16_t* PROJ = (bf16_t*)(ws + WS_PROJ); float* GU = (float*)(ws + WS_PROJ); bf16_t* CONTRIB = (bf16_t*)(ws + WS_PROJ);
    bf16_t* Y = (bf16_t*)(ws + WS_Y); bf16_t* Z = (bf16_t*)(ws + WS_Z); bf16_t* HID = (bf16_t*)(ws + WS_HID);
    float4* SLOT = (float4*)(ws + WS_SLOT); int* TOKSLOT = (int*)(ws + WS_TOKSLOT); float2* PS = (float2*)(ws + WS_PSTATS);
    (void)GU; (void)PROJ; (void)CONTRIB; (void)HID; (void)XB; (void)WGU; (void)WD; (void)WIN; (void)WOUT;
    Args a{}; for (int i = 0; i < 22; ++i) a.in[i] = (const float*)d_in[i]; a.out = (float*)d_out; a.ws = (unsigned char*)d_ws;
    g_li = 0;

    (void)hipMemsetAsync(ws + WS_CTL, 0, CTL_BYTES, stream);
#if MK_ALL
    mk_launch(a, 0, 8, stream);
    return;
#endif
#if MK_P0
    mk_launch(a, 0, 1, stream);
#else
    k_cvt_x<<<2048, 256, 0, stream>>>(x, XB, (size_t)T * D / 4);
    k_tconv<<<dim3(NPROJ / 32, D / 32, 1), dim3(32, 8), 0, stream>>>(w_in, D, NPROJ, 0, WIN, 0, nullptr, NPROJ, 0, 0);
    k_tconv<<<dim3(D / 32, D / 32, 1), dim3(32, 8), 0, stream>>>(w_out, D, D, 0, WOUT, 0, nullptr, D, 0, 0);
    k_zero16<<<256, 256, 0, stream>>>(WR, (size_t)256 * D);
    k_tconv<<<dim3(1, D / 32, 1), dim3(32, 8), 0, stream>>>(rew, D, 32, 0, WR, 0, g1, 32, 0, 4);
    k_foldvec<<<dim3(1, 1), 64, 0, stream>>>(rew, D, 32, 0, g1, b1, reb, vec + V_SR, vec + V_TR, 0, 32, 0, 4);
    k_foldvec<<<dim3(1, 1), 64, 0, stream>>>(rgw, D, 4, 0, g1, b1, rgb, vec + V_SR, vec + V_TR, 0, 4, 0, 0);
    k_tconv<<<dim3(DE / 32, D / 32, NE), dim3(32, 8), 0, stream>>>(wg, D, DE, (size_t)D * DE, WGU, (size_t)512 * D, g1, 128, 256, 0);
    k_tconv<<<dim3(DE / 32, D / 32, NE), dim3(32, 8), 0, stream>>>(wu, D, DE, (size_t)D * DE, WGU, (size_t)512 * D, g1, 128, 256, 128);
    k_foldvec<<<dim3(1, NE), 256, 0, stream>>>(wg, D, DE, (size_t)D * DE, g1, b1, nullptr, vec + V_SGU, vec + V_TGU, 512, 128, 256, 0);
    k_foldvec<<<dim3(1, NE), 256, 0, stream>>>(wu, D, DE, (size_t)D * DE, g1, b1, nullptr, vec + V_SGU, vec + V_TGU, 512, 128, 256, 128);
    k_tconv<<<dim3(D / 32, DE / 32, NE), dim3(32, 8), 0, stream>>>(wd, DE, D, (size_t)DE * D, WD, (size_t)D * DE, nullptr, D, 0, 0);
    k_sp<<<2, 256, 0, stream>>>(lam, vec + V_SP);
    k_tconv4<<<16, 256, 0, stream>>>(rgw, g1, WR);
#endif
#if MK_P1
    mk_launch(a, 1, 2, stream);
#else
    { FProj f{XB, WIN, PROJ, 0, 0}; k_ngemm<<<dim3(NPROJ / 64, T / 64), 256, 0, stream>>>(f); }
#endif
#if MK_P2
    mk_launch(a, 2, 3, stream);
#else
    k_mix_rg<<<NBATCH * 8, 64, 0, stream>>>(PROJ, rg_cw, rg_cb, Wa, ba, Wx, bx, vec + V_SP, Y);
    k_mix_sc<<<(unsigned)(((size_t)T * DRG + 255) / 256), 256, 0, stream>>>(PROJ, sc_cw, Y);
#endif
#if MK_P3
    mk_launch(a, 3, 4, stream);
#else
    { FOut f{Y, WOUT, XB, Z, 0, 0}; k_ngemm<<<dim3(D / 64, T / 64), 256, 0, stream>>>(f); }
    k_pstats<<<T * 16 / 256, 256, 0, stream>>>(Z, PS);
#endif
#if MK_P4
    mk_launch(a, 4, 5, stream);
#else
    k_router<<<T, 64, 0, stream>>>(Z, WR, PS, vec + V_SR, vec + V_TR, cnt, SLOT, TOKSLOT);
#endif
    k_base<<<1, 64, 0, stream>>>(cnt, base);
#if MK_P5
    mk_launch(a, 5, 6, stream);
#else
    { FGateUp f{Z, WGU, SLOT, cnt, base, vec + V_SGU, vec + V_TGU, GU, 0, 0, 0, 0}; k_ngemm<<<dim3(512 / 64, T / 64, NE), 256, 0, stream>>>(f); }
    k_hid<<<dim3(1, T, NE), 256, 0, stream>>>(GU, SLOT, cnt, base, HID);
#endif
#if MK_P6
    mk_launch(a, 6, 7, stream);
#else
    { FDown f{HID, WD, cnt, base, CONTRIB, 0, 0, 0, 0}; k_ngemm<<<dim3(D / 64, T / 64, NE), 256, 0, stream>>>(f); }
#endif
#if MK_P7
    mk_launch(a, 7, 8, stream);
#else
    k_final<<<T, 64, 0, stream>>>(Z, PS, TOKSLOT, base, CONTRIB, g1, b1, g2, b2, (float*)d_out);
#endif
}
```

```cpp
#include <hip/hip_runtime.h>
#include <stdint.h>
#include <math.h>
#define MK_ALL 1
#define MK_MIX_SIMPLE 0
#define MK_P0 1
#define MK_P1 1
#define MK_P2 1
#define MK_P3 1
#define MK_P4 1
#define MK_P5 1
#define MK_P6 1
#define MK_P7 1

typedef unsigned short bf16_t;
typedef float f32x4 __attribute__((ext_vector_type(4)));

constexpr int T = 32768, D = 1024, SEQ = 2048, NBATCH = 16;
constexpr int DRG = 512, NPROJ = 2560, NE = 32, DE = 256, NGRP = 4, EPG = 8;
constexpr float LN_EPS = 1e-5f;
constexpr float ALPHA = 1.189207115002721f;
constexpr int SLOT_ROWS = 2 * T + NE * 256;

constexpr size_t MiB = 1u << 20;
constexpr size_t WS_CTL = 0;
constexpr size_t CTL_BYTES = 1 * MiB;
constexpr size_t WS_VEC = 1 * MiB;
constexpr size_t WS_WIN = 2 * MiB;
constexpr size_t WS_WOUT = 7 * MiB;
constexpr size_t WS_WR = 9 * MiB;
constexpr size_t WS_WGU = 10 * MiB;
constexpr size_t WS_WD = 42 * MiB;
constexpr size_t WS_XB = 60 * MiB;
constexpr size_t WS_PROJ = 124 * MiB;
constexpr size_t WS_Y = 284 * MiB;
constexpr size_t WS_Z = 348 * MiB;
constexpr size_t WS_HID = 412 * MiB;
constexpr size_t WS_SLOT = 448 * MiB;
constexpr size_t WS_TOKSLOT = 464 * MiB;
constexpr size_t WS_PSTATS = 465 * MiB;
constexpr size_t WS_END = 470 * MiB;

constexpr int V_SR = 0, V_TR = 256, V_SGU = 512, V_TGU = V_SGU + NE * 512, V_SP = V_TGU + NE * 512, V_BASE = V_SP + 512;

__device__ __forceinline__ unsigned f2bf(float f) { unsigned u = __builtin_bit_cast(unsigned, f); return (u + 0x7fffu + ((u >> 16) & 1u)) >> 16; }
__device__ __forceinline__ float bf2f(unsigned h) { return __builtin_bit_cast(float, (h & 0xffffu) << 16); }
__device__ __forceinline__ float sigmoidf_(float x) { return 1.f / (1.f + __expf(-x)); }
__device__ __forceinline__ float gelu_tanh(float x) { const float u = 0.7978845608028654f * (x + 0.044715f * x * x * x); return 0.5f * x * (1.f + tanhf(u)); }

__global__ void k_cvt_x(const float* __restrict__ x, bf16_t* __restrict__ xb, size_t n4) {
    for (size_t i = blockIdx.x * (size_t)blockDim.x + threadIdx.x; i < n4; i += (size_t)gridDim.x * blockDim.x) {
        const f32x4 v = ((const f32x4*)x)[i];
        uint2 o; o.x = f2bf(v.x) | (f2bf(v.y) << 16); o.y = f2bf(v.z) | (f2bf(v.w) << 16);
        ((uint2*)xb)[i] = o;
    }
}
__global__ void k_tconv(const float* __restrict__ W, int K, int N, size_t wbs, bf16_t* __restrict__ WT, size_t tbs, const float* __restrict__ scale, int blk, int stride, int off) {
    __shared__ float tile[32][33];
    const int e = blockIdx.z; W += e * wbs; WT += e * tbs;
    const int n0 = blockIdx.x * 32, k0 = blockIdx.y * 32, tx = threadIdx.x, ty = threadIdx.y;
    for (int j = ty; j < 32; j += 8) { const int k = k0 + j, n = n0 + tx; tile[j][tx] = (scale ? scale[k] : 1.f) * W[(size_t)k * N + n]; }
    __syncthreads();
    for (int j = ty; j < 32; j += 8) { const int n = n0 + j, k = k0 + tx; const int dr = (n / blk) * stride + off + n % blk; WT[(size_t)dr * K + k] = (bf16_t)f2bf(tile[tx][j]); }
}
__global__ void k_zero16(bf16_t* p, size_t n) { for (size_t i = blockIdx.x * (size_t)blockDim.x + threadIdx.x; i < n; i += (size_t)gridDim.x * blockDim.x) p[i] = 0; }
__global__ void k_foldvec(const float* __restrict__ W, int K, int N, size_t wbs, const float* __restrict__ g, const float* __restrict__ b, const float* __restrict__ bias,
                          float* __restrict__ S, float* __restrict__ Tv, size_t vbs, int blk, int stride, int off) {
    const int e = blockIdx.y; W += e * wbs; S += e * vbs; Tv += e * vbs;
    const int n = blockIdx.x * blockDim.x + threadIdx.x; if (n >= N) return;
    float s = 0.f, t = 0.f;
    for (int k = 0; k < K; ++k) { const float w = W[(size_t)k * N + n]; s += g[k] * w; t += b[k] * w; }
    const int dr = (n / blk) * stride + off + n % blk;
    S[dr] = s; Tv[dr] = t + (bias ? bias[n] : 0.f);
}
__global__ void k_sp(const float* __restrict__ lam, float* __restrict__ sp) { const int c = threadIdx.x + blockIdx.x * blockDim.x; if (c < DRG) sp[c] = 8.0f * log1pf(expf(-lam[c])); }

template <class F> __global__ void __launch_bounds__(256) k_ngemm(F f) {
    __shared__ float As[64][33], Bs[64][33];
    if (!f.setup()) return;
    const int tid = threadIdx.x, tx = tid & 15, ty = tid >> 4;
    const int lr = tid >> 2, lk = (tid & 3) * 8;
    const bf16_t* ap = f.arow(lr); const bf16_t* bp = f.brow(lr);
    float acc[4][4] = {};
    const int K = f.K();
    for (int k0 = 0; k0 < K; k0 += 32) {
        uint4 av = make_uint4(0, 0, 0, 0), bv = make_uint4(0, 0, 0, 0);
        if (ap) av = *(const uint4*)(ap + k0 + lk);
        if (bp) bv = *(const uint4*)(bp + k0 + lk);
        const unsigned aw[4] = {av.x, av.y, av.z, av.w}, bw[4] = {bv.x, bv.y, bv.z, bv.w};
#pragma unroll
        for (int j = 0; j < 4; ++j) { As[lr][lk + 2 * j] = bf2f(aw[j]); As[lr][lk + 2 * j + 1] = bf2f(aw[j] >> 16); Bs[lr][lk + 2 * j] = bf2f(bw[j]); Bs[lr][lk + 2 * j + 1] = bf2f(bw[j] >> 16); }
        __syncthreads();
#pragma unroll 8
        for (int k = 0; k < 32; ++k) {
            float a[4], b[4];
#pragma unroll
            for (int i = 0; i < 4; ++i) { a[i] = As[ty * 4 + i][k]; b[i] = Bs[tx * 4 + i][k]; }
#pragma unroll
            for (int i = 0; i < 4; ++i)
#pragma unroll
                for (int j = 0; j < 4; ++j) acc[i][j] += a[i] * b[j];
        }
        __syncthreads();
    }
#pragma unroll
    for (int i = 0; i < 4; ++i)
#pragma unroll
        for (int j = 0; j < 4; ++j) f.out(ty * 4 + i, tx * 4 + j, acc[i][j]);
}

struct FProj {
    const bf16_t* A; const bf16_t* Bt; bf16_t* O; int r0, c0;
    __device__ bool setup() { r0 = blockIdx.y * 64; c0 = blockIdx.x * 64; return true; }
    __device__ const bf16_t* arow(int r) const { return A + (size_t)(r0 + r) * D; }
    __device__ const bf16_t* brow(int c) const { return Bt + (size_t)(c0 + c) * D; }
    __device__ int K() const { return D; }
    __device__ void out(int r, int c, float v) const { O[(size_t)(r0 + r) * NPROJ + c0 + c] = (bf16_t)f2bf(v); }
};
struct FOut {
    const bf16_t* A; const bf16_t* Bt; const bf16_t* XB; bf16_t* Z; int r0, c0;
    __device__ bool setup() { r0 = blockIdx.y * 64; c0 = blockIdx.x * 64; return true; }
    __device__ const bf16_t* arow(int r) const { return A + (size_t)(r0 + r) * D; }
    __device__ const bf16_t* brow(int c) const { return Bt + (size_t)(c0 + c) * D; }
    __device__ int K() const { return D; }
    __device__ void out(int r, int c, float v) const { const size_t i = (size_t)(r0 + r) * D + c0 + c; Z[i] = (bf16_t)f2bf(ALPHA * bf2f(XB[i]) + v); }
};
struct FGateUp {
    const bf16_t* Z; const bf16_t* WGU; const float4* SLOT; const int* cnt; const int* base; const float* SGU; const float* TGU; float* GU; int e, p0, c0, ne;
    __device__ bool setup() { e = blockIdx.z; ne = cnt[e]; p0 = blockIdx.y * 64; c0 = blockIdx.x * 64; return p0 < ne; }
    __device__ const bf16_t* arow(int r) const { const int pos = p0 + r; if (pos >= ne) return nullptr; const int tok = __builtin_bit_cast(int, SLOT[(size_t)e * T + pos].x); return Z + (size_t)tok * D; }
    __device__ const bf16_t* brow(int c) const { return WGU + ((size_t)e * 512 + c0 + c) * D; }
    __device__ int K() const { return D; }
    __device__ void out(int r, int c, float v) const { const int pos = p0 + r; if (pos >= ne) return; const float4 si = SLOT[(size_t)e * T + pos];
        const int n = c0 + c; GU[(size_t)(base[e] + pos) * 512 + n] = si.y * (v - si.z * SGU[e * 512 + n]) + TGU[e * 512 + n]; }
};
struct FDown {
    const bf16_t* HID; const bf16_t* WD; const int* cnt; const int* base; bf16_t* C; int e, p0, c0, ne;
    __device__ bool setup() { e = blockIdx.z; ne = cnt[e]; p0 = blockIdx.y * 64; c0 = blockIdx.x * 64; return p0 < ne; }
    __device__ const bf16_t* arow(int r) const { const int pos = p0 + r; if (pos >= ne) return nullptr; return HID + (size_t)(base[e] + pos) * DE; }
    __device__ const bf16_t* brow(int c) const { return WD + ((size_t)e * D + c0 + c) * DE; }
    __device__ int K() const { return DE; }
    __device__ void out(int r, int c, float v) const { const int pos = p0 + r; if (pos >= ne) return; C[(size_t)(base[e] + pos) * D + c0 + c] = (bf16_t)f2bf(v); }
};

__global__ void __launch_bounds__(64) k_mix_rg(const bf16_t* __restrict__ PROJ, const float* __restrict__ cw, const float* __restrict__ cb, const float* __restrict__ Wa, const float* __restrict__ ba,
                                               const float* __restrict__ Wx, const float* __restrict__ bx, const float* __restrict__ sp, bf16_t* __restrict__ Y) {
    __shared__ float wa[64][64], wx[64][64], xs[64];
    const int b = blockIdx.x >> 3, h = blockIdx.x & 7, lane = threadIdx.x, c = h * 64 + lane;
    for (int i = 0; i < 64; ++i) { wa[i][lane] = Wa[(h * 64 + i) * 64 + lane]; wx[i][lane] = Wx[(h * 64 + i) * 64 + lane]; }
    const float w0 = cw[0 * DRG + c], w1 = cw[1 * DRG + c], w2 = cw[2 * DRG + c], w3 = cw[3 * DRG + c], cbias = cb[c], bac = ba[c], bxc = bx[c], spc = sp[c];
    float x0 = 0.f, x1 = 0.f, x2 = 0.f, hs = 0.f;
    __syncthreads();
    for (int t = 0; t < SEQ; ++t) {
        const size_t row = (size_t)b * SEQ + t;
        const float x3 = bf2f(PROJ[row * NPROJ + c]);
        const float xc = cbias + w0 * x0 + w1 * x1 + w2 * x2 + w3 * x3;
        x0 = x1; x1 = x2; x2 = x3;
        xs[lane] = xc;
        __syncthreads();
        float ra = bac, rx = bxc;
#pragma unroll 8
        for (int i = 0; i < 64; ++i) { const float v = xs[i]; ra += v * wa[i][lane]; rx += v * wx[i][lane]; }
        const float r = sigmoidf_(ra), ii = sigmoidf_(rx);
        const float la = -spc * r, a = expf(la), mult = sqrtf(-expm1f(2.f * la));
        hs = a * hs + mult * (ii * xc);
        const float gate = bf2f(PROJ[row * NPROJ + DRG + c]);
        Y[row * D + c] = (bf16_t)f2bf(hs * gelu_tanh(gate));
        __syncthreads();
    }
}
__global__ void k_mix_sc(const bf16_t* __restrict__ PROJ, const float* __restrict__ scw, bf16_t* __restrict__ Y) {
    const size_t i = blockIdx.x * (size_t)blockDim.x + threadIdx.x; if (i >= (size_t)T * DRG) return;
    const int c = (int)(i % DRG); const size_t row = i / DRG; const int t = (int)(row % SEQ);
    float s = 0.f;
#pragma unroll
    for (int k = 0; k < 3; ++k) { const int tt = t - 2 + k; if (tt >= 0) { const size_t r2 = row - 2 + k; s += scw[k * DRG + c] * (bf2f(PROJ[r2 * NPROJ + 1536 + c]) * bf2f(PROJ[r2 * NPROJ + 2048 + c])); } }
    Y[row * D + DRG + c] = (bf16_t)f2bf(bf2f(PROJ[row * NPROJ + 1024 + c]) * s);
}
__global__ void k_pstats(const bf16_t* __restrict__ Z, float2* __restrict__ PS) {
    const size_t i = blockIdx.x * (size_t)blockDim.x + threadIdx.x; if (i >= (size_t)T * 16) return;
    const int pn = (int)((i >> 2) & 3), wc = (int)(i & 3);
    const bf16_t* p = Z + (i >> 4) * D + pn * 256 + wc * 32; float s = 0.f, q = 0.f;
    for (int bj = 0; bj < 2; ++bj) for (int k = 0; k < 32; ++k) { const float v = bf2f(p[bj * 128 + k]); s += v; q += v * v; }
    PS[i] = make_float2(s, q);
}
__device__ __forceinline__ void row_stats(const float2* PS, int t, float& mu, float& rstd) {
    float s = 0.f, q = 0.f;
#pragma unroll
    for (int j = 0; j < 16; ++j) { const float2 a = PS[(size_t)t * 16 + j]; s += a.x; q += a.y; }
    mu = s * (1.f / D); const float var = q * (1.f / D) - mu * mu; rstd = 1.f / sqrtf(fmaxf(var, 0.f) + LN_EPS);
}
__global__ void __launch_bounds__(64) k_router(const bf16_t* __restrict__ Z, const bf16_t* __restrict__ WR, const float2* __restrict__ PS, const float* __restrict__ SR, const float* __restrict__ TR,
                                               int* __restrict__ cnt, float4* __restrict__ SLOT, int* __restrict__ TOKSLOT) {
    __shared__ float lg[64];
    const int t = blockIdx.x, lane = threadIdx.x;
    float mu, rstd; row_stats(PS, t, mu, rstd);
    if (lane < 36) { float s = 0.f; const bf16_t* z = Z + (size_t)t * D; const bf16_t* w = WR + (size_t)lane * D;
        for (int k = 0; k < D; ++k) s += bf2f(z[k]) * bf2f(w[k]);
        lg[lane] = rstd * (s - mu * SR[lane]) + TR[lane]; }
    __syncthreads();
    if (lane == 0) {
        int g = 0; float gm = lg[0];
        for (int j = 1; j < NGRP; ++j) if (lg[j] > gm) { gm = lg[j]; g = j; }
        float den = 0.f; for (int j = 0; j < NGRP; ++j) den += expf(lg[j] - gm);
        const float gp = 1.f / den;
        const float* el = lg + 4 + g * EPG;
        int i1 = 0; float v1 = el[0];
        for (int j = 1; j < EPG; ++j) if (el[j] > v1) { v1 = el[j]; i1 = j; }
        int i2 = -1; float v2 = -INFINITY;
        for (int j = 0; j < EPG; ++j) if (j != i1 && el[j] > v2) { v2 = el[j]; i2 = j; }
        const float e2 = expf(v2 - v1), w1 = gp / (1.f + e2), w2 = gp * e2 / (1.f + e2);
        const int ea = g * EPG + i1, eb = g * EPG + i2;
        const int pa = atomicAdd(&cnt[ea], 1), pb = atomicAdd(&cnt[eb], 1);
        SLOT[(size_t)ea * T + pa] = make_float4(__builtin_bit_cast(float, t), rstd, mu, w1);
        SLOT[(size_t)eb * T + pb] = make_float4(__builtin_bit_cast(float, t), rstd, mu, w2);
        TOKSLOT[t * 2 + 0] = ea * T + pa; TOKSLOT[t * 2 + 1] = eb * T + pb;
    }
}
__global__ void k_base(const int* __restrict__ cnt, int* __restrict__ base) { if (threadIdx.x == 0) { int s = 0; for (int e = 0; e < NE; ++e) { base[e] = s; s += (cnt[e] + 255) / 256 * 256; } base[NE] = s; } }
__global__ void k_hid(const float* __restrict__ GU, const float4* __restrict__ SLOT, const int* __restrict__ cnt, const int* __restrict__ base, bf16_t* __restrict__ HID) {
    const int e = blockIdx.z, pos = blockIdx.y, f = threadIdx.x; if (pos >= cnt[e]) return;
    const size_t row = (size_t)base[e] + pos; const int j = f >> 7, fl = f & 127;
    const float g = GU[row * 512 + 256 * j + fl], u = GU[row * 512 + 256 * j + 128 + fl], cw = SLOT[(size_t)e * T + pos].w;
    HID[row * DE + f] = (bf16_t)f2bf(g * sigmoidf_(g) * u * cw);
}
__global__ void __launch_bounds__(64) k_final(const bf16_t* __restrict__ Z, const float2* __restrict__ PS, const int* __restrict__ TOKSLOT, const int* __restrict__ base, const bf16_t* __restrict__ C,
                                              const float* __restrict__ g1, const float* __restrict__ b1, const float* __restrict__ g2, const float* __restrict__ b2, float* __restrict__ out) {
    const int t = blockIdx.x, lane = threadIdx.x;
    float mu, rstd; row_stats(PS, t, mu, rstd);
    const int s1 = TOKSLOT[t * 2], s2 = TOKSLOT[t * 2 + 1];
    const size_t r1 = (size_t)base[s1 / T] + s1 % T, r2 = (size_t)base[s2 / T] + s2 % T;
    float v[16]; float s = 0.f;
#pragma unroll
    for (int j = 0; j < 16; ++j) { const int c = j * 64 + lane; const float h1 = (bf2f(Z[(size_t)t * D + c]) - mu) * rstd * g1[c] + b1[c];
        v[j] = ALPHA * h1 + bf2f(C[r1 * D + c]) + bf2f(C[r2 * D + c]); s += v[j]; }
    for (int o = 1; o < 64; o <<= 1) s += __shfl_xor(s, o);
    const float m2 = s * (1.f / D); float q = 0.f;
#pragma unroll
    for (int j = 0; j < 16; ++j) { const float d = v[j] - m2; q += d * d; }
    for (int o = 1; o < 64; o <<= 1) q += __shfl_xor(q, o);
    const float r2s = 1.f / sqrtf(q * (1.f / D) + LN_EPS);
#pragma unroll
    for (int j = 0; j < 16; ++j) { const int c = j * 64 + lane; out[(size_t)t * D + c] = (v[j] - m2) * r2s * g2[c] + b2[c]; }
}

__global__ void k_tconv4(const float* __restrict__ W, const float* __restrict__ g, bf16_t* __restrict__ WT) {
    const int i = blockIdx.x * blockDim.x + threadIdx.x; if (i >= 4 * D) return; const int n = i / D, k = i % D; WT[(size_t)n * D + k] = (bf16_t)f2bf(g[k] * W[k * 4 + n]);
}


#define LAS __attribute__((address_space(3)))
#define GAS __attribute__((address_space(1)))
typedef short bf16x8 __attribute__((ext_vector_type(8)));
typedef unsigned u32x4 __attribute__((ext_vector_type(4)));
typedef float f32x2 __attribute__((ext_vector_type(2)));
namespace pg8 {
constexpr int BM = 256, BK = 64, HALF = 128, HTB = HALF * BK * 2, STAGE_BYTES = 8 * HTB, NXCD = 8, WGM = 8;
__host__ __device__ __forceinline__ int lds_byte(int r, int c) { const int st = (r >> 4) * 2 + (c >> 5), rr = r & 15, cc = c & 31, ob = rr * 64 + cc * 2; return st * 1024 + (ob ^ (((ob >> 9) & 1) << 5)); }
__host__ __device__ __forceinline__ void stage_rc(int b, int& R, int& C) { const int st = b / 1024, sb = b % 1024, swz = sb ^ (((sb >> 9) & 1) << 5); R = (st >> 1) * 16 + swz / 64; C = (st & 1) * 32 + (swz % 64) / 2; }
__host__ __device__ __forceinline__ int perm32(int rho) { const int n = rho >> 4, i = rho & 15; return 8 * (i >> 2) + 4 * n + (i & 3); }
__device__ __forceinline__ unsigned cvt_pk_bf16(float lo, float hi) { unsigned r; asm volatile("v_cvt_pk_bf16_f32 %0, %1, %2" : "=v"(r) : "v"(lo), "v"(hi)); return r; }

struct Unit { int pm, pn, e, tl; };

__device__ __forceinline__ int xcd_remap(int L, int nwg) { const int q = nwg / NXCD, r = nwg % NXCD, xcd = L % NXCD, off = L / NXCD; return (xcd < r ? xcd * (q + 1) : r * (q + 1) + (xcd - r) * q) + off; }
struct StaticOrder {
    int nM, nN, nwg, G, c;
    __device__ void init(int M, int N, int G_, int c_) { nM = M / BM; nN = N / BM; nwg = nM * nN; G = G_; c = c_; }
    __device__ bool next(int i, Unit& u) const {
        const long L = (long)i * G + c; if (L >= nwg) return false;
        const int wgid = xcd_remap((int)L, nwg);
        const int nig = WGM * nN, gid = wgid / nig, fm = gid * WGM, gsz = (nM - fm) < WGM ? (nM - fm) : WGM;
        u.pm = fm + ((wgid % nig) % gsz); u.pn = (wgid % nig) / gsz; u.e = 0; u.tl = 0; return true;
    }
};
struct MoeOrder {
    const LAS int* pref;
    int NP, nunits, G, c;
    __device__ bool next(int i, Unit& u) const {
        const long L = (long)i * G + c; if (L >= nunits) return false;
        const int wgid = xcd_remap((int)L, nunits);
        const int tg = wgid / NP, pl = wgid % NP;
        int e = 0; while (pref[e + 1] <= tg) ++e;
        e = __builtin_amdgcn_readfirstlane(e);
        u.pm = __builtin_amdgcn_readfirstlane(tg); u.e = e; u.tl = __builtin_amdgcn_readfirstlane(tg - pref[e]); u.pn = e * NP + pl; return true;
    }
};
struct DenseA { static constexpr bool GATHER = false; };
struct GatherA { static constexpr bool GATHER = true; const LAS int* toks; };

struct EpiBf16 {
    static constexpr bool PERM = true;
    bf16_t* O; int ldc; int cmask;
    __device__ __forceinline__ void operator()(const f32x4 (&acc)[2][2][4][2], const Unit& u, int wr, int wc, int fr, int fq) const {
        const int row0 = u.pm * BM + wr * 64 + fr, col0 = (u.pn & cmask) * BM + wc * 32 + 8 * fq;
#pragma unroll
        for (int ai = 0; ai < 2; ++ai)
#pragma unroll
            for (int m = 0; m < 4; ++m) { bf16_t* rowp = O + (size_t)(row0 + ai * HALF + m * 16) * ldc + col0;
#pragma unroll
                for (int bj = 0; bj < 2; ++bj) { const f32x4 v0 = acc[ai][bj][m][0], v1 = acc[ai][bj][m][1];
                    u32x4 w; w.x = cvt_pk_bf16(v0[0], v0[1]); w.y = cvt_pk_bf16(v0[2], v0[3]); w.z = cvt_pk_bf16(v1[0], v1[1]); w.w = cvt_pk_bf16(v1[2], v1[3]);
                    *(u32x4*)(rowp + bj * HALF) = w; } }
    }
};
struct EpiZ {
    static constexpr bool PERM = true;
    const bf16_t* XB; bf16_t* Z; float2* PS;
    __device__ __forceinline__ void operator()(const f32x4 (&acc)[2][2][4][2], const Unit& u, int wr, int wc, int fr, int fq) const {
        const int row0 = u.pm * BM + wr * 64 + fr, col0 = u.pn * BM + wc * 32 + 8 * fq;
#pragma unroll
        for (int ai = 0; ai < 2; ++ai)
#pragma unroll
            for (int m = 0; m < 4; ++m) { const int r = row0 + ai * HALF + m * 16; const size_t off = (size_t)r * D + col0; float s = 0.f, q = 0.f;
#pragma unroll
                for (int bj = 0; bj < 2; ++bj) { const u32x4 xv = *(const u32x4*)(XB + off + bj * HALF); const f32x4 v0 = acc[ai][bj][m][0], v1 = acc[ai][bj][m][1];
                    u32x4 w;
                    w.x = cvt_pk_bf16(ALPHA * bf2f(xv.x) + v0[0], ALPHA * bf2f(xv.x >> 16) + v0[1]); w.y = cvt_pk_bf16(ALPHA * bf2f(xv.y) + v0[2], ALPHA * bf2f(xv.y >> 16) + v0[3]);
                    w.z = cvt_pk_bf16(ALPHA * bf2f(xv.z) + v1[0], ALPHA * bf2f(xv.z >> 16) + v1[1]); w.w = cvt_pk_bf16(ALPHA * bf2f(xv.w) + v1[2], ALPHA * bf2f(xv.w >> 16) + v1[3]);
                    *(u32x4*)(Z + off + bj * HALF) = w;
                    const unsigned ww[4] = {w.x, w.y, w.z, w.w};
#pragma unroll
                    for (int k = 0; k < 4; ++k) { const float a = bf2f(ww[k]), b = bf2f(ww[k] >> 16); s += a + b; q += a * a + b * b; } }
                s += __shfl_xor(s, 16); s += __shfl_xor(s, 32); q += __shfl_xor(q, 16); q += __shfl_xor(q, 32);
                if (fq == 0) PS[(size_t)r * 16 + u.pn * 4 + wc] = make_float2(s, q); }
    }
};
struct EpiLogits {
    static constexpr bool PERM = true;
    float* LG;
    __device__ __forceinline__ void operator()(const f32x4 (&acc)[2][2][4][2], const Unit& u, int wr, int wc, int fr, int fq) const {
        if (wc >= 2) return;
        const int row0 = u.pm * BM + wr * 64 + fr, col0 = wc * 32 + 8 * fq;
#pragma unroll
        for (int ai = 0; ai < 2; ++ai)
#pragma unroll
            for (int m = 0; m < 4; ++m) { float* p = LG + (size_t)(row0 + ai * HALF + m * 16) * 64 + col0; *(f32x4*)p = acc[ai][0][m][0]; *(f32x4*)(p + 4) = acc[ai][0][m][1]; }
    }
};
struct EpiGU {
    static constexpr bool PERM = true;
    const float4* SLOT; const float* SGU; const float* TGU; bf16_t* HID;
    __device__ __forceinline__ void operator()(const f32x4 (&acc)[2][2][4][2], const Unit& u, int wr, int wc, int fr, int fq) const {
        const int e = u.e, j = u.pn & 1, fcol = wc * 32 + 8 * fq;
        const float* sgp = SGU + e * 512 + 256 * j + fcol; const float* tgp = TGU + e * 512 + 256 * j + fcol;
        const f32x4 sg0 = *(const f32x4*)(sgp), sg1 = *(const f32x4*)(sgp + 4), su0 = *(const f32x4*)(sgp + 128), su1 = *(const f32x4*)(sgp + 132);
        const f32x4 tg0 = *(const f32x4*)(tgp), tg1 = *(const f32x4*)(tgp + 4), tu0 = *(const f32x4*)(tgp + 128), tu1 = *(const f32x4*)(tgp + 132);
#pragma unroll
        for (int ai = 0; ai < 2; ++ai)
#pragma unroll
            for (int m = 0; m < 4; ++m) { const int rl = ai * HALF + wr * 64 + m * 16 + fr;
                const float4 si = SLOT[(size_t)e * T + u.tl * BM + rl]; const float rstd = si.y, rm = si.y * si.z, cw = si.w;
                float h[8];
#pragma unroll
                for (int n = 0; n < 2; ++n) { const f32x4 ag = acc[ai][0][m][n], au = acc[ai][1][m][n]; const f32x4 sg = n ? sg1 : sg0, su = n ? su1 : su0, tg = n ? tg1 : tg0, tu = n ? tu1 : tu0;
#pragma unroll
                    for (int k = 0; k < 4; ++k) { const float g = rstd * ag[k] - rm * sg[k] + tg[k], uu = rstd * au[k] - rm * su[k] + tu[k];
                        h[4 * n + k] = g * __builtin_amdgcn_rcpf(1.f + __expf(-g)) * uu * cw; } }
                u32x4 w; w.x = cvt_pk_bf16(h[0], h[1]); w.y = cvt_pk_bf16(h[2], h[3]); w.z = cvt_pk_bf16(h[4], h[5]); w.w = cvt_pk_bf16(h[6], h[7]);
                *(u32x4*)(HID + (size_t)(u.pm * BM + rl) * DE + 128 * j + fcol) = w; }
    }
};

template <class Epi, class Sched, class ASrc, bool ALIGN_EPI>
__device__ __forceinline__ void gemm_phase(LAS unsigned char* lds, const bf16_t* Ag, const bf16_t* Btg, const int K, const Sched& S, const Epi& E, const ASrc& AS) {
    const int tid = threadIdx.x, wid = __builtin_amdgcn_readfirstlane(tid >> 6), lane = tid & 63, wr = wid >> 2, wc = wid & 3, fr = lane & 15, fq = lane >> 4;
    const int nt = K / BK;
    unsigned voffA[2], voffB[2]; int RA[2], CA[2];
#pragma unroll
    for (int i = 0; i < 2; ++i) { int R, C; stage_rc(tid * 16 + i * 8192, R, C); const int Rb = Epi::PERM ? ((R & ~31) + perm32(R & 31)) : R; RA[i] = R; CA[i] = C;
        voffA[i] = (unsigned)(R * K + C) * 2u; voffB[i] = (unsigned)(Rb * K + C) * 2u; }
    const size_t kstep = (size_t)(BK * 2);
    const size_t hstep = (size_t)HALF * K * 2;
    const size_t tstep = 2 * hstep;
    const unsigned ldsw = (unsigned)wid * 1024u;
    const int aoff = lds_byte(wr * 64 + fr, fq * 8), boff = lds_byte(wc * 32 + fr, fq * 8);
#define PG8_SA(b, h) (((b) * 2 + (h)) * HTB)
#define PG8_SB(b, h) ((4 + (b) * 2 + (h)) * HTB)
#define PG8_STAGE(bufoff, gbase, voff) do { _Pragma("unroll") for (int _i = 0; _i < 2; ++_i) \
        __builtin_amdgcn_global_load_lds((const unsigned*)((const char*)(gbase) + (voff)[_i]), (LAS unsigned*)(lds + (bufoff) + ldsw + _i * 8192), 16, 0, 0); } while (0)
#define PG8_LDA(dst, b, h) do { _Pragma("unroll") for (int m = 0; m < 4; ++m) _Pragma("unroll") for (int k = 0; k < 2; ++k) dst[m][k] = *(const LAS bf16x8*)(lds + PG8_SA(b, h) + aoff + m * 2048 + k * 1024); } while (0)
#define PG8_LDB(dst, b, h) do { _Pragma("unroll") for (int n = 0; n < 2; ++n) _Pragma("unroll") for (int k = 0; k < 2; ++k) dst[n][k] = *(const LAS bf16x8*)(lds + PG8_SB(b, h) + boff + n * 2048 + k * 1024); } while (0)
#define PG8_MMA(ai, bj, At, Bt) do { __builtin_amdgcn_s_setprio(1); _Pragma("unroll") for (int m = 0; m < 4; ++m) _Pragma("unroll") for (int n = 0; n < 2; ++n) _Pragma("unroll") for (int k = 0; k < 2; ++k) \
        acc[ai][bj][m][n] = __builtin_amdgcn_mfma_f32_16x16x32_bf16(Bt[n][k], At[m][k], acc[ai][bj][m][n], 0, 0, 0); __builtin_amdgcn_s_setprio(0); } while (0)
#define PG8_WAIT_V(n) asm volatile("s_waitcnt vmcnt(" #n ")" ::: "memory")
#define PG8_WAIT_L(n) asm volatile("s_waitcnt lgkmcnt(" #n ")" ::: "memory")
#define PG8_BAR __builtin_amdgcn_s_barrier()
#define PG8_SCHED __builtin_amdgcn_sched_barrier(0)
#define PG8_GOFF(dst, uidx) do { if constexpr (ASrc::GATHER) { _Pragma("unroll") for (int _h = 0; _h < 2; ++_h) _Pragma("unroll") for (int _i = 0; _i < 2; ++_i) \
        dst[_h][_i] = (unsigned)(AS.toks[(uidx) * BM + _h * HALF + RA[_i]] * K + CA[_i]) * 2u; } } while (0)
#define PG8_AVO(h, nextc) (ASrc::GATHER ? ((nextc) ? nvo[h] : cvo[h]) : voffA)
    Unit cur, nxt; int ui = 0;
    if (!S.next(0, cur)) return;
    f32x4 acc[2][2][4][2];
#pragma unroll
    for (int a = 0; a < 2; ++a)
#pragma unroll
        for (int b = 0; b < 2; ++b)
#pragma unroll
            for (int m = 0; m < 4; ++m)
#pragma unroll
                for (int n = 0; n < 2; ++n) acc[a][b][m][n] = (f32x4){0.f, 0.f, 0.f, 0.f};
    bf16x8 At[4][2], B0[2][2], B1[2][2];
    unsigned cvo[2][2], nvo[2][2];
    if constexpr (ASrc::GATHER) { PG8_GOFF(cvo, 0);
#pragma unroll
        for (int h = 0; h < 2; ++h) { nvo[h][0] = cvo[h][0]; nvo[h][1] = cvo[h][1]; } }
    const char* cA0 = ASrc::GATHER ? (const char*)Ag : (const char*)Ag + (size_t)cur.pm * tstep; const char* cA1 = ASrc::GATHER ? cA0 : cA0 + hstep;
    const char* cB = (const char*)Btg + (size_t)cur.pn * tstep;
    PG8_STAGE(PG8_SB(0, 0), cB, voffB); PG8_STAGE(PG8_SB(0, 1), cB + hstep, voffB); PG8_STAGE(PG8_SA(0, 0), cA0, PG8_AVO(0, false)); PG8_STAGE(PG8_SA(0, 1), cA1, PG8_AVO(1, false));
    if (wr == 1) PG8_BAR;
    PG8_WAIT_V(2); PG8_BAR;
    PG8_STAGE(PG8_SB(1, 0), cB + kstep, voffB); PG8_STAGE(PG8_SA(1, 0), cA0 + kstep, PG8_AVO(0, false)); PG8_STAGE(PG8_SB(1, 1), cB + hstep + kstep, voffB);
    PG8_WAIT_V(6); PG8_BAR;
#define PG8_KBODY() do { \
            const bool last = (t == nt - 2); \
            const char* a1_1 = cA1 + (size_t)(t + 1) * kstep; \
            const char* a2_0 = last ? nA0 : cA0 + (size_t)(t + 2) * kstep; const char* a2_1 = last ? nA1 : cA1 + (size_t)(t + 2) * kstep; \
            const char* b2 = last ? nB : cB + (size_t)(t + 2) * kstep; const char* a3_0 = a2_0 + kstep; const char* b3 = b2 + kstep; \
            unsigned vs[2][2]; if constexpr (ASrc::GATHER) { _Pragma("unroll") for (int _h = 0; _h < 2; ++_h) _Pragma("unroll") for (int _i = 0; _i < 2; ++_i) vs[_h][_i] = last ? nvo[_h][_i] : cvo[_h][_i]; } \
            PG8_LDB(B0, 0, 0); PG8_LDB(B1, 0, 1); PG8_SCHED; PG8_LDA(At, 0, 0); PG8_STAGE(PG8_SA(1, 1), a1_1, PG8_AVO(1, false)); \
            PG8_WAIT_V(8); PG8_WAIT_L(0); PG8_BAR; PG8_MMA(0, 0, At, B0); PG8_MMA(0, 1, At, B1); PG8_BAR; PG8_SCHED; \
            PG8_LDA(At, 0, 1); PG8_STAGE(PG8_SB(0, 0), b2, voffB); PG8_STAGE(PG8_SB(0, 1), b2 + hstep, voffB); PG8_STAGE(PG8_SA(0, 0), a2_0, (ASrc::GATHER ? vs[0] : voffA)); \
            PG8_WAIT_V(8); PG8_WAIT_L(0); PG8_BAR; PG8_MMA(1, 0, At, B0); PG8_MMA(1, 1, At, B1); PG8_BAR; PG8_SCHED; \
            PG8_LDB(B0, 1, 0); PG8_LDB(B1, 1, 1); PG8_SCHED; PG8_LDA(At, 1, 0); PG8_STAGE(PG8_SA(0, 1), a2_1, (ASrc::GATHER ? vs[1] : voffA)); \
            PG8_WAIT_V(8); PG8_WAIT_L(0); PG8_BAR; PG8_MMA(0, 0, At, B0); PG8_MMA(0, 1, At, B1); PG8_BAR; PG8_SCHED; \
            PG8_LDA(At, 1, 1); PG8_STAGE(PG8_SB(1, 0), b3, voffB); PG8_STAGE(PG8_SB(1, 1), b3 + hstep, voffB); PG8_STAGE(PG8_SA(1, 0), a3_0, (ASrc::GATHER ? vs[0] : voffA)); \
            PG8_WAIT_V(8); PG8_WAIT_L(0); PG8_BAR; PG8_MMA(1, 0, At, B0); PG8_MMA(1, 1, At, B1); PG8_BAR; PG8_SCHED; } while (0)
    for (;;) {
        const bool has_next = S.next(ui + 1, nxt);
        const char* nA0 = cA0; const char* nA1 = cA1; const char* nB = cB;
        if (has_next) { nA0 = ASrc::GATHER ? (const char*)Ag : (const char*)Ag + (size_t)nxt.pm * tstep; nA1 = ASrc::GATHER ? nA0 : nA0 + hstep; nB = (const char*)Btg + (size_t)nxt.pn * tstep;
            if constexpr (ASrc::GATHER) { PG8_GOFF(nvo, ui + 1); } }
#pragma nounroll
        for (int t = 0; t < nt; t += 2) PG8_KBODY();
        if constexpr (ALIGN_EPI) { if (wr == 0) PG8_BAR; }
        E(acc, cur, wr, wc, fr, fq);
        if (!has_next) break;
#pragma unroll
        for (int a = 0; a < 2; ++a)
#pragma unroll
            for (int b = 0; b < 2; ++b)
#pragma unroll
                for (int m = 0; m < 4; ++m)
#pragma unroll
                    for (int n = 0; n < 2; ++n) acc[a][b][m][n] = (f32x4){0.f, 0.f, 0.f, 0.f};
        cur = nxt; cA0 = nA0; cA1 = nA1; cB = nB; ++ui;
        if constexpr (ASrc::GATHER) {
#pragma unroll
            for (int h = 0; h < 2; ++h) { cvo[h][0] = nvo[h][0]; cvo[h][1] = nvo[h][1]; } }
        if constexpr (ALIGN_EPI) { if (wr == 1) PG8_BAR; }
    }
    PG8_WAIT_V(0);
    if constexpr (!ALIGN_EPI) { if (wr == 0) PG8_BAR; }
    PG8_BAR;
#undef PG8_KBODY
#undef PG8_GOFF
#undef PG8_AVO
#undef PG8_SA
#undef PG8_SB
#undef PG8_STAGE
#undef PG8_LDA
#undef PG8_LDB
#undef PG8_MMA
#undef PG8_WAIT_V
#undef PG8_WAIT_L
#undef PG8_BAR
#undef PG8_SCHED
}
}

constexpr int NWAVES = 8;
constexpr int RING_OFF = 0, RING_BYTES = 131072;
constexpr int LDSCTL_OFF = RING_BYTES, MISC_OFF = LDSCTL_OFF + 320;
constexpr int LDS_BYTES = 147456;
constexpr int NPHASE = 8;
constexpr int CW_CNT = 0;
constexpr int CW_BAR = 4096;

#define XB_TMO      128
#define XB_XCNT(j)  (256  + 64 * (j))
#define XB_XSUB(j)  (1280 + 64 * (j))
#define XB_XGEN(j)  (2304 + 64 * (j))
#define XB_TOP      3328
#define XB_TOPGEN   3392
#define XCD_BAR_WORDS 3456
#define XB_SPIN_CAP (1u << 18)
__device__ __forceinline__ unsigned xb_ld(unsigned* p)              { return __hip_atomic_load(p, __ATOMIC_RELAXED, __HIP_MEMORY_SCOPE_AGENT); }
__device__ __forceinline__ unsigned xb_add(unsigned* p, unsigned v) { return __hip_atomic_fetch_add(p, v, __ATOMIC_RELAXED, __HIP_MEMORY_SCOPE_AGENT); }
__device__ __forceinline__ unsigned xb_xcc_id() { return (unsigned)__builtin_amdgcn_s_getreg((3 << 11) | 20) & 0xFu; }
#define XB_SPIN(cond, bar) do { unsigned _sp = 0; while (cond) { __builtin_amdgcn_s_sleep(1); \
    if ((++_sp & 255u) == 0u) { if (xb_ld(&(bar)[XB_TMO])) break; if (_sp > XB_SPIN_CAP) { atomicAdd(&(bar)[XB_TMO], 1u); break; } } } } while (0)
struct XcdBarrier { unsigned* bar; unsigned x; volatile LAS unsigned* st; };
__device__ __forceinline__ XcdBarrier xcd_barrier_post(unsigned* bar, volatile LAS unsigned* st) {
    XcdBarrier b; b.bar = bar; b.x = xb_xcc_id(); b.st = st;
    if (threadIdx.x == 0) (void)xb_add(&bar[XB_XCNT(b.x)], 1u);
    return b;
}
__device__ __forceinline__ void xcd_barrier_complete(unsigned* bar, unsigned x, unsigned& nloc, unsigned& nx) {
    const unsigned G = gridDim.x * gridDim.y * gridDim.z;
    unsigned sum, cnt, mine, sp = 0u;
    for (;;) {
        sum = 0u; cnt = 0u; mine = 0u;
#pragma unroll
        for (unsigned j = 0; j < 16; ++j) { const unsigned c = xb_ld(&bar[XB_XCNT(j)]); sum += c; cnt += (c > 0u) ? 1u : 0u; mine = (j == x) ? c : mine; }
        if (sum == G) break;
        __builtin_amdgcn_s_sleep(1);
        if ((++sp & 255u) == 0u) { if (xb_ld(&bar[XB_TMO])) break; if (sp > XB_SPIN_CAP) { atomicAdd(&bar[XB_TMO], 1u); break; } }
    }
    nloc = mine > 0u ? mine : 1u; nx = cnt > 0u ? cnt : 1u;
}
__device__ __forceinline__ void xcd_barrier(const XcdBarrier& b) {
    asm volatile("s_waitcnt vmcnt(0)" ::: "memory");
    __syncthreads();
    if (threadIdx.x == 0) {
        unsigned* bar = b.bar;
        __builtin_amdgcn_s_waitcnt(0);
        unsigned nloc = b.st[0], nx = b.st[1];
        if (nloc == 0u) { xcd_barrier_complete(bar, b.x, nloc, nx); b.st[0] = nloc; b.st[1] = nx; }
        const unsigned old = xb_add(&bar[XB_XSUB(b.x)], 1u);
        const unsigned gen = old / nloc;
        if (old + 1u == (gen + 1u) * nloc) {
            __builtin_amdgcn_fence(__ATOMIC_RELEASE, "agent");
            asm volatile("s_waitcnt vmcnt(0)" ::: "memory");
            const unsigned og = xb_add(&bar[XB_TOP], 1u);
            const unsigned tg = og / nx;
            if (og + 1u == (tg + 1u) * nx) xb_add(&bar[XB_TOPGEN], 1u);
            else XB_SPIN(xb_ld(&bar[XB_TOPGEN]) == tg, bar);
            __builtin_amdgcn_fence(__ATOMIC_ACQUIRE, "agent");
            xb_add(&bar[XB_XGEN(b.x)], 1u);
            asm volatile("s_waitcnt vmcnt(0)" ::: "memory");
        } else {
            XB_SPIN(xb_ld(&bar[XB_XGEN(b.x)]) == gen, bar);
            __builtin_amdgcn_fence(__ATOMIC_ACQUIRE, "agent");
            asm volatile("s_waitcnt vmcnt(0)" ::: "memory");
        }
    }
    __syncthreads();
}

struct Args { const float* in[22]; float* out; unsigned char* ws; int ph_lo, ph_hi, li, pad; };


#define LDS_WAIT() asm volatile("s_waitcnt lgkmcnt(0)" ::: "memory")
#define VM_WAIT() asm volatile("s_waitcnt vmcnt(0)" ::: "memory")
__device__ __forceinline__ unsigned pk2(float lo, float hi) { return f2bf(lo) | (f2bf(hi) << 16); }
__device__ __forceinline__ float wave_sum(float v) {
#pragma unroll
    for (int o = 1; o < 64; o <<= 1) v += __shfl_xor(v, o);
    return v;
}
__device__ __forceinline__ void p0_transpose_item(const float* __restrict__ W, int K, int N, bf16_t* __restrict__ WT, const float* __restrict__ scale, int blk, int stride, int off, LAS float* scr, int item, int lane) {
    const int nblk = N / 32, kb = item / nblk, nb = item % nblk, k0 = 64 * kb, n0 = 32 * nb;
#pragma unroll 8
    for (int i = 0; i < 32; ++i) { const int kk = 2 * i + (lane >> 5); float w = W[(size_t)(k0 + kk) * N + n0 + (lane & 31)]; if (scale) w *= scale[k0 + kk]; scr[kk * 33 + (lane & 31)] = w; }
    LDS_WAIT();
    const int c = lane & 7;
#pragma unroll
    for (int j = 0; j < 4; ++j) { const int n = (lane >> 3) + 8 * j; const LAS float* sp = scr + (8 * c) * 33 + n;
        u32x4 o; o.x = pk2(sp[0 * 33], sp[1 * 33]); o.y = pk2(sp[2 * 33], sp[3 * 33]); o.z = pk2(sp[4 * 33], sp[5 * 33]); o.w = pk2(sp[6 * 33], sp[7 * 33]);
        const int nn = n0 + n, dr = (nn / blk) * stride + off + nn % blk;
        *(u32x4*)(WT + (size_t)dr * K + k0 + 8 * c) = o; }
    LDS_WAIT();
}
__device__ __forceinline__ void p0_prologue(const Args& args, unsigned char* ws, LAS unsigned char* lds, int G) {
    const int tid = threadIdx.x, lane = tid & 63, wave = __builtin_amdgcn_readfirstlane(tid >> 6);
    const float* x = args.in[0]; const float* w_in = args.in[1]; const float* lam = args.in[8]; const float* w_out = args.in[10]; const float* g1 = args.in[11]; const float* b1 = args.in[12];
    const float* rgw = args.in[13]; const float* rgb = args.in[14]; const float* rew = args.in[15]; const float* reb = args.in[16];
    const float* wg = args.in[17]; const float* wu = args.in[18]; const float* wd = args.in[19];
    float* vec = (float*)(ws + WS_VEC);
    bf16_t* WIN = (bf16_t*)(ws + WS_WIN); bf16_t* WOUT = (bf16_t*)(ws + WS_WOUT); bf16_t* WR = (bf16_t*)(ws + WS_WR); bf16_t* WGU = (bf16_t*)(ws + WS_WGU); bf16_t* WD = (bf16_t*)(ws + WS_WD);
    bf16_t* XB = (bf16_t*)(ws + WS_XB);
    LAS float* scr = (LAS float*)(lds + wave * 16384);
    const int gw = (int)blockIdx.x * NWAVES + wave, NGW = G * NWAVES;
    const size_t gtid = (size_t)blockIdx.x * (NWAVES * 64) + tid, NT = (size_t)G * NWAVES * 64;
    constexpr int I_IN = (D / 64) * (NPROJ / 32), I_OUT = (D / 64) * (D / 32), I_RE = (D / 64), I_G = (D / 64) * (DE / 32), I_D = (DE / 64) * (D / 32);
    constexpr int NITEMS = I_IN + I_OUT + I_RE + NE * (2 * I_G + I_D);
    for (int it = gw; it < NITEMS; it += NGW) {
        int r = it;
        if (r < I_IN) { p0_transpose_item(w_in, D, NPROJ, WIN, nullptr, NPROJ, 0, 0, scr, r, lane); continue; } r -= I_IN;
        if (r < I_OUT) { p0_transpose_item(w_out, D, D, WOUT, nullptr, D, 0, 0, scr, r, lane); continue; } r -= I_OUT;
        if (r < I_RE) { p0_transpose_item(rew, D, 32, WR, g1, 32, 0, 4, scr, r, lane); continue; } r -= I_RE;
        if (r < NE * I_G) { const int e = r / I_G; p0_transpose_item(wg + (size_t)e * D * DE, D, DE, WGU + (size_t)e * 512 * D, g1, 128, 256, 0, scr, r % I_G, lane); continue; } r -= NE * I_G;
        if (r < NE * I_G) { const int e = r / I_G; p0_transpose_item(wu + (size_t)e * D * DE, D, DE, WGU + (size_t)e * 512 * D, g1, 128, 256, 128, scr, r % I_G, lane); continue; } r -= NE * I_G;
        { const int e = r / I_D; p0_transpose_item(wd + (size_t)e * DE * D, DE, D, WD + (size_t)e * D * DE, nullptr, D, 0, 0, scr, r % I_D, lane); }
    }
    for (size_t i = gtid; i < (size_t)4 * D; i += NT) { const int n = (int)(i / D), k = (int)(i % D); WR[(size_t)n * D + k] = (bf16_t)f2bf(g1[k] * rgw[k * 4 + n]); }
    for (size_t i = gtid; i < (size_t)220 * D / 8; i += NT) ((u32x4*)(WR + 36 * D))[i] = (u32x4){0u, 0u, 0u, 0u};
    if (gw % 7 == 0 && gw / 7 < 257) {
        const int it = gw / 7;
        if (it < 256) { const int e = it >> 3, cb = it & 7, n = (cb & 3) * 64 + lane; const float* W = (cb < 4 ? wg : wu) + (size_t)e * D * DE + n;
            float sa = 0.f, ta = 0.f;
#pragma unroll 8
            for (int k = 0; k < D; ++k) { const float w = W[(size_t)k * DE]; sa += g1[k] * w; ta += b1[k] * w; }
            const int dr = (n / 128) * 256 + (cb < 4 ? 0 : 128) + n % 128; vec[V_SGU + e * 512 + dr] = sa; vec[V_TGU + e * 512 + dr] = ta;
        } else if (lane < 36) {
            float sa = 0.f, ta = 0.f;
            for (int k = 0; k < D; ++k) { const float w = lane < 4 ? rgw[k * 4 + lane] : rew[k * 32 + lane - 4]; sa += g1[k] * w; ta += b1[k] * w; }
            vec[V_SR + lane] = sa; vec[V_TR + lane] = ta + (lane < 4 ? rgb[lane] : reb[lane - 4]);
        }
    }
    if (gtid < DRG) vec[V_SP + gtid] = 8.0f * log1pf(expf(-lam[gtid]));
    for (size_t i = gtid; i < (size_t)T * D / 8; i += NT) { const f32x4 a = ((const f32x4*)x)[2 * i], b = ((const f32x4*)x)[2 * i + 1];
        u32x4 o; o.x = pk2(a.x, a.y); o.y = pk2(a.z, a.w); o.z = pk2(b.x, b.y); o.w = pk2(b.z, b.w); ((u32x4*)XB)[i] = o; }
}
__device__ __forceinline__ void p2_mixer_simple(const Args& args, unsigned char* ws, LAS unsigned char* lds, int G) {
    const int tid = threadIdx.x, lane = tid & 63, wave = __builtin_amdgcn_readfirstlane(tid >> 6);
    const float* cw = args.in[2]; const float* cb = args.in[3]; const float* Wa = args.in[4]; const float* ba = args.in[5]; const float* Wx = args.in[6]; const float* bx = args.in[7]; const float* scw = args.in[9];
    const float* sp = (const float*)(ws + WS_VEC) + V_SP;
    const bf16_t* PROJ = (const bf16_t*)(ws + WS_PROJ); bf16_t* Y = (bf16_t*)(ws + WS_Y);
    if (wave == 0) {
        LAS float* wa = (LAS float*)lds; LAS float* wx = wa + 4096; LAS float* xs = wx + 4096;
        for (int item = blockIdx.x; item < NBATCH * 8; item += G) {
            const int b = item >> 3, h = item & 7, c = h * 64 + lane;
            for (int i = 0; i < 64; ++i) { wa[i * 64 + lane] = Wa[(h * 64 + i) * 64 + lane]; wx[i * 64 + lane] = Wx[(h * 64 + i) * 64 + lane]; }
            const float w0 = cw[0 * DRG + c], w1 = cw[1 * DRG + c], w2 = cw[2 * DRG + c], w3 = cw[3 * DRG + c], cbias = cb[c], bac = ba[c], bxc = bx[c], spc = sp[c];
            float x0 = 0.f, x1 = 0.f, x2 = 0.f, hs = 0.f;
            LDS_WAIT();
            for (int t = 0; t < SEQ; ++t) {
                const size_t row = (size_t)b * SEQ + t;
                const float x3 = bf2f(PROJ[row * NPROJ + c]);
                const float xc = cbias + w0 * x0 + w1 * x1 + w2 * x2 + w3 * x3;
                x0 = x1; x1 = x2; x2 = x3;
                xs[lane] = xc;
                LDS_WAIT();
                float ra = bac, rx = bxc;
#pragma unroll 8
                for (int i = 0; i < 64; ++i) { const float v = xs[i]; ra += v * wa[i * 64 + lane]; rx += v * wx[i * 64 + lane]; }
                const float r = sigmoidf_(ra), ii = sigmoidf_(rx);
                const float la = -spc * r, a = __expf(la), mult = sqrtf(fmaxf(1.f - a * a, 0.f));
                hs = a * hs + mult * (ii * xc);
                const float gate = bf2f(PROJ[row * NPROJ + DRG + c]);
                Y[row * D + c] = (bf16_t)f2bf(hs * gelu_tanh(gate));
                LDS_WAIT();
            }
        }
    }
    const size_t gtid = (size_t)blockIdx.x * (NWAVES * 64) + tid, NT = (size_t)G * NWAVES * 64;
    for (size_t i = gtid; i < (size_t)T * DRG; i += NT) {
        const int c = (int)(i % DRG); const size_t row = i / DRG; const int t = (int)(row % SEQ);
        float s = 0.f;
#pragma unroll
        for (int k = 0; k < 3; ++k) { const int tt = t - 2 + k; if (tt >= 0) { const size_t r2 = row - 2 + k; s += scw[k * DRG + c] * (bf2f(PROJ[r2 * NPROJ + 1536 + c]) * bf2f(PROJ[r2 * NPROJ + 2048 + c])); } }
        Y[row * D + DRG + c] = (bf16_t)f2bf(bf2f(PROJ[row * NPROJ + 1024 + c]) * s);
    }
}

namespace mix {
constexpr int L = 128, NCH = SEQ / L;
constexpr int XT_OFF = 0, GT_OFF = 16896, AT_OFF = GT_OFF + 8192, A_OFF = AT_OFF + 16384, U_OFF = A_OFF + 16384, YT_OFF = U_OFF + 16384, SEG_OFF = YT_OFF + 8192, HC_OFF = SEG_OFF + 4096;
__device__ __forceinline__ float sigm(float x) { return __builtin_amdgcn_rcpf(1.f + __expf(-x)); }
__device__ __forceinline__ float gelu_t(float x) { const float u = 1.5957691216057308f * (x + 0.044715f * x * x * x); return x * __builtin_amdgcn_rcpf(1.f + __expf(-u)); }
}
__device__ __forceinline__ void p2_mixer(const Args& args, unsigned char* ws, LAS unsigned char* lds, int G) {
    using namespace mix;
    const int tid = threadIdx.x, lane = tid & 63, wave = __builtin_amdgcn_readfirstlane(tid >> 6), fr = lane & 15, fq = lane >> 4;
    const float* cw = args.in[2]; const float* cb = args.in[3]; const float* Wa = args.in[4]; const float* ba = args.in[5]; const float* Wx = args.in[6]; const float* bx = args.in[7]; const float* scw = args.in[9];
    const float* sp = (const float*)(ws + WS_VEC) + V_SP;
    const bf16_t* PROJ = (const bf16_t*)(ws + WS_PROJ); bf16_t* Y = (bf16_t*)(ws + WS_Y);
    LAS unsigned char* XT = lds + XT_OFF; LAS unsigned char* GT = lds + GT_OFF; LAS unsigned char* AT = lds + AT_OFF; LAS float* At_ = (LAS float*)(lds + A_OFF); LAS float* Ut_ = (LAS float*)(lds + U_OFF);
    LAS unsigned char* YT = lds + YT_OFF; LAS f32x2* SEG = (LAS f32x2*)(lds + SEG_OFF); LAS float* HC = (LAS float*)(lds + HC_OFF);
    for (int item = blockIdx.x; item < NBATCH * 16; item += G) {
        const int b = item >> 4, h = (item >> 1) & 7, half = item & 1;
        const size_t rowb = (size_t)b * SEQ;
        const int c8 = tid & 7;
        float cwt[4][8], cbi[8];
#pragma unroll
        for (int k = 0; k < 4; ++k) { const f32x4 a = *(const f32x4*)(cw + k * DRG + h * 64 + 8 * c8), bq = *(const f32x4*)(cw + k * DRG + h * 64 + 8 * c8 + 4);
            cwt[k][0] = a.x; cwt[k][1] = a.y; cwt[k][2] = a.z; cwt[k][3] = a.w; cwt[k][4] = bq.x; cwt[k][5] = bq.y; cwt[k][6] = bq.z; cwt[k][7] = bq.w; }
        { const f32x4 a = *(const f32x4*)(cb + h * 64 + 8 * c8), bq = *(const f32x4*)(cb + h * 64 + 8 * c8 + 4); cbi[0] = a.x; cbi[1] = a.y; cbi[2] = a.z; cbi[3] = a.w; cbi[4] = bq.x; cbi[5] = bq.y; cbi[6] = bq.z; cbi[7] = bq.w; }
        bf16x8 Bf[2][2][2];
#pragma unroll
        for (int gt = 0; gt < 2; ++gt)
#pragma unroll
            for (int nb = 0; nb < 2; ++nb)
#pragma unroll
                for (int ks = 0; ks < 2; ++ks) { const float* Wp = (gt ? Wx : Wa) + ((size_t)h * 64 + 32 * ks + 8 * fq) * 64 + half * 32 + 16 * nb + fr; bf16x8 v;
#pragma unroll
                    for (int e = 0; e < 8; ++e) v[e] = (short)f2bf(Wp[e * 64]);
                    Bf[gt][nb][ks] = v; }
        float bae[2], bxe[2], spe[2];
#pragma unroll
        for (int nb = 0; nb < 2; ++nb) { const int j = h * 64 + half * 32 + 16 * nb + fr; bae[nb] = ba[j]; bxe[nb] = bx[j]; spe[nb] = sp[j]; }
        if (tid < 64) HC[tid] = 0.f;
        u32x4 px[3], pg;
#define MIX_LOAD(ch) do { const int t0_ = (ch) * L; \
            _Pragma("unroll") for (int i = 0; i < 3; ++i) { const int p = tid + 512 * i; const int r = p >> 3, tt = t0_ - 3 + r; px[i] = (u32x4){0u, 0u, 0u, 0u}; \
                if (p < 131 * 8 && tt >= 0) px[i] = *(const u32x4*)(PROJ + (rowb + tt) * NPROJ + h * 64 + 8 * (p & 7)); } \
            pg = *(const u32x4*)(PROJ + (rowb + t0_ + (tid >> 2)) * NPROJ + DRG + h * 64 + half * 32 + 8 * (tid & 3)); } while (0)
        MIX_LOAD(0);
        for (int ch = 0; ch < NCH; ++ch) {
            const int t0 = ch * L;
#pragma unroll
            for (int i = 0; i < 3; ++i) { const int p = tid + 512 * i; if (p < 131 * 8) *(LAS u32x4*)(XT + p * 16) = px[i]; }
            *(LAS u32x4*)(GT + tid * 16) = pg;
            __syncthreads();
            if (ch + 1 < NCH) MIX_LOAD(ch + 1);
#pragma unroll
            for (int k2 = 0; k2 < 2; ++k2) { const int t = (tid >> 3) + 64 * k2; float acc8[8];
#pragma unroll
                for (int e = 0; e < 8; ++e) acc8[e] = cbi[e];
#pragma unroll
                for (int k = 0; k < 4; ++k) { const u32x4 v = *(const LAS u32x4*)(XT + (t + k) * 128 + c8 * 16); const unsigned w4[4] = {v.x, v.y, v.z, v.w};
#pragma unroll
                    for (int e = 0; e < 4; ++e) { acc8[2 * e] += cwt[k][2 * e] * bf2f(w4[e]); acc8[2 * e + 1] += cwt[k][2 * e + 1] * bf2f(w4[e] >> 16); } }
                u32x4 o; o.x = pk2(acc8[0], acc8[1]); o.y = pk2(acc8[2], acc8[3]); o.z = pk2(acc8[4], acc8[5]); o.w = pk2(acc8[6], acc8[7]);
                *(LAS u32x4*)(AT + t * 128 + ((c8 ^ (t & 7)) << 4)) = o; }
            __syncthreads();
            f32x4 accg[2][2];
            { const int t = 16 * wave + fr; bf16x8 Af[2];
#pragma unroll
                for (int ks = 0; ks < 2; ++ks) Af[ks] = *(const LAS bf16x8*)(AT + t * 128 + (((ks * 4 + fq) ^ (t & 7)) << 4));
#pragma unroll
                for (int gt = 0; gt < 2; ++gt)
#pragma unroll
                    for (int nb = 0; nb < 2; ++nb) { f32x4 c = {0.f, 0.f, 0.f, 0.f};
#pragma unroll
                        for (int ks = 0; ks < 2; ++ks) c = __builtin_amdgcn_mfma_f32_16x16x32_bf16(Af[ks], Bf[gt][nb][ks], c, 0, 0, 0);
                        accg[gt][nb] = c; } }
#pragma unroll
            for (int nb = 0; nb < 2; ++nb)
#pragma unroll
                for (int rg = 0; rg < 4; ++rg) { const int t = 16 * wave + 4 * fq + rg, jj = 16 * nb + fr, ci = half * 32 + jj;
                    const float xc = bf2f(*(const LAS unsigned short*)(AT + t * 128 + (((ci >> 3) ^ (t & 7)) << 4) + (ci & 7) * 2));
                    const float r = sigm(accg[0][nb][rg] + bae[nb]), ig = sigm(accg[1][nb][rg] + bxe[nb]);
                    const float a = __expf(-spe[nb] * r), mult = __builtin_amdgcn_sqrtf(fmaxf(1.f - a * a, 0.f));
                    At_[t * 32 + jj] = a; Ut_[t * 32 + jj] = mult * ig * xc; }
            __syncthreads();
            { const int jj = tid & 31, seg = tid >> 5; float av[8], uv[8]; float Aq = 1.f, Hq = 0.f;
#pragma unroll
                for (int s2 = 0; s2 < 8; ++s2) { av[s2] = At_[(8 * seg + s2) * 32 + jj]; uv[s2] = Ut_[(8 * seg + s2) * 32 + jj]; Hq = av[s2] * Hq + uv[s2]; Aq *= av[s2]; }
                SEG[seg * 32 + jj] = (f32x2){Aq, Hq};
                __syncthreads();
                float hh = HC[(ch & 1) * 32 + jj];
                for (int q = 0; q < seg; ++q) { const f32x2 sg = SEG[q * 32 + jj]; hh = sg.x * hh + sg.y; }
                if (seg == 15) HC[((ch + 1) & 1) * 32 + jj] = Aq * hh + Hq;
#pragma unroll
                for (int s2 = 0; s2 < 8; ++s2) { const int t = 8 * seg + s2; hh = av[s2] * hh + uv[s2];
                    const float gv = bf2f(*(const LAS unsigned short*)(GT + t * 64 + jj * 2));
                    *(LAS unsigned short*)(YT + t * 64 + jj * 2) = (unsigned short)f2bf(hh * gelu_t(gv)); } }
            __syncthreads();
            *(u32x4*)(Y + (rowb + t0 + (tid >> 2)) * D + h * 64 + half * 32 + 8 * (tid & 3)) = *(const LAS u32x4*)(YT + tid * 16);
        }
#undef MIX_LOAD
        __syncthreads();
    }
    {
        const int c0 = 8 * lane;
        float w3[3][8];
#pragma unroll
        for (int k = 0; k < 3; ++k) { const f32x4 a = *(const f32x4*)(scw + k * DRG + c0), bq = *(const f32x4*)(scw + k * DRG + c0 + 4);
            w3[k][0] = a.x; w3[k][1] = a.y; w3[k][2] = a.z; w3[k][3] = a.w; w3[k][4] = bq.x; w3[k][5] = bq.y; w3[k][6] = bq.z; w3[k][7] = bq.w; }
        for (int it = (int)blockIdx.x * NWAVES + wave; it < T / 16; it += G * NWAVES) {
            const size_t r0 = (size_t)it * 16; const int tq = (int)(r0 % SEQ);
            float cv1[8], cv2[8];
#pragma unroll
            for (int e = 0; e < 8; ++e) { cv1[e] = 0.f; cv2[e] = 0.f; }
            if (tq > 0) {
#pragma unroll
                for (int hh = 0; hh < 2; ++hh) { const size_t r = r0 - 2 + hh; const u32x4 cc = *(const u32x4*)(PROJ + r * NPROJ + 1536 + c0), vv = *(const u32x4*)(PROJ + r * NPROJ + 2048 + c0);
                    const unsigned cw4[4] = {cc.x, cc.y, cc.z, cc.w}, vw4[4] = {vv.x, vv.y, vv.z, vv.w};
#pragma unroll
                    for (int e = 0; e < 4; ++e) { const float p0 = bf2f(cw4[e]) * bf2f(vw4[e]), p1 = bf2f(cw4[e] >> 16) * bf2f(vw4[e] >> 16);
                        if (hh == 0) { cv2[2 * e] = p0; cv2[2 * e + 1] = p1; } else { cv1[2 * e] = p0; cv1[2 * e + 1] = p1; } } } }
#pragma unroll 4
            for (int s2 = 0; s2 < 16; ++s2) { const size_t r = r0 + s2;
                const u32x4 bb = *(const u32x4*)(PROJ + r * NPROJ + 1024 + c0), cc = *(const u32x4*)(PROJ + r * NPROJ + 1536 + c0), vv = *(const u32x4*)(PROJ + r * NPROJ + 2048 + c0);
                const unsigned bw4[4] = {bb.x, bb.y, bb.z, bb.w}, cw4[4] = {cc.x, cc.y, cc.z, cc.w}, vw4[4] = {vv.x, vv.y, vv.z, vv.w};
                float yv[8];
#pragma unroll
                for (int e = 0; e < 4; ++e) { const float p0 = bf2f(cw4[e]) * bf2f(vw4[e]), p1 = bf2f(cw4[e] >> 16) * bf2f(vw4[e] >> 16);
                    yv[2 * e] = bf2f(bw4[e]) * (w3[0][2 * e] * cv2[2 * e] + w3[1][2 * e] * cv1[2 * e] + w3[2][2 * e] * p0);
                    yv[2 * e + 1] = bf2f(bw4[e] >> 16) * (w3[0][2 * e + 1] * cv2[2 * e + 1] + w3[1][2 * e + 1] * cv1[2 * e + 1] + w3[2][2 * e + 1] * p1);
                    cv2[2 * e] = cv1[2 * e]; cv2[2 * e + 1] = cv1[2 * e + 1]; cv1[2 * e] = p0; cv1[2 * e + 1] = p1; }
                u32x4 o; o.x = pk2(yv[0], yv[1]); o.y = pk2(yv[2], yv[3]); o.z = pk2(yv[4], yv[5]); o.w = pk2(yv[6], yv[7]);
                *(u32x4*)(Y + r * D + DRG + c0) = o; }
        }
    }
}
__device__ __forceinline__ void p4_route_tile(int pm, const float* __restrict__ LG, const float2* __restrict__ PS, const float* __restrict__ SR, const float* __restrict__ TR,
                                              unsigned* cnt, float4* __restrict__ SLOT, int* __restrict__ TOKSLOT, volatile LAS unsigned* MISC) {
    const int tid = threadIdx.x;
    LAS unsigned* hist = (LAS unsigned*)(MISC + 96); LAS unsigned* gbase = (LAS unsigned*)(MISC + 128);
    if (tid < 32) hist[tid] = 0u;
    __syncthreads();
    int ea = 0, eb = 0; unsigned ra = 0, rb = 0; float w1 = 0.f, w2 = 0.f, mu = 0.f, rstd = 0.f; const int t = pm * 256 + tid;
    if (tid < 256) {
        float s = 0.f, q = 0.f;
#pragma unroll
        for (int j = 0; j < 8; ++j) { const f32x4 a = *(const f32x4*)((const float*)(PS + (size_t)t * 16) + 4 * j); s += a.x + a.z; q += a.y + a.w; }
        mu = s * (1.f / D); rstd = 1.f / sqrtf(fmaxf(q * (1.f / D) - mu * mu, 0.f) + LN_EPS);
        float lg[36];
#pragma unroll
        for (int j = 0; j < 9; ++j) { const f32x4 a = *(const f32x4*)(LG + (size_t)t * 64 + 4 * j); lg[4 * j] = a.x; lg[4 * j + 1] = a.y; lg[4 * j + 2] = a.z; lg[4 * j + 3] = a.w; }
#pragma unroll
        for (int j = 0; j < 36; ++j) lg[j] = rstd * (lg[j] - mu * SR[j]) + TR[j];
        int g = 0; float gm = lg[0];
#pragma unroll
        for (int j = 1; j < NGRP; ++j) if (lg[j] > gm) { gm = lg[j]; g = j; }
        float den = 0.f;
#pragma unroll
        for (int j = 0; j < NGRP; ++j) den += __expf(lg[j] - gm);
        const float gp = 1.f / den;
        float el[EPG];
#pragma unroll
        for (int j = 0; j < EPG; ++j) el[j] = g == 0 ? lg[4 + j] : g == 1 ? lg[12 + j] : g == 2 ? lg[20 + j] : lg[28 + j];
        int i1 = 0; float v1 = el[0];
#pragma unroll
        for (int j = 1; j < EPG; ++j) if (el[j] > v1) { v1 = el[j]; i1 = j; }
        int i2 = 0; float v2 = -INFINITY;
#pragma unroll
        for (int j = 0; j < EPG; ++j) if (j != i1 && el[j] > v2) { v2 = el[j]; i2 = j; }
        const float e2 = __expf(v2 - v1); w1 = gp / (1.f + e2); w2 = gp * e2 / (1.f + e2);
        ea = g * EPG + i1; eb = g * EPG + i2;
        ra = __hip_atomic_fetch_add(&hist[ea], 1u, __ATOMIC_RELAXED, __HIP_MEMORY_SCOPE_WORKGROUP); rb = __hip_atomic_fetch_add(&hist[eb], 1u, __ATOMIC_RELAXED, __HIP_MEMORY_SCOPE_WORKGROUP);
    }
    __syncthreads();
    if (tid < 32) gbase[tid] = hist[tid] ? __hip_atomic_fetch_add(cnt + tid, hist[tid], __ATOMIC_RELAXED, __HIP_MEMORY_SCOPE_AGENT) : 0u;
    __syncthreads();
    if (tid < 256) {
        const int pa = (int)(gbase[ea] + ra), pb = (int)(gbase[eb] + rb);
        SLOT[(size_t)ea * T + pa] = make_float4(__builtin_bit_cast(float, t), rstd, mu, w1);
        SLOT[(size_t)eb * T + pb] = make_float4(__builtin_bit_cast(float, t), rstd, mu, w2);
        TOKSLOT[t * 2 + 0] = ea * T + pa; TOKSLOT[t * 2 + 1] = eb * T + pb;
    }
    __syncthreads();
}
__device__ __forceinline__ void p7_final(const Args& args, unsigned char* ws, const LAS int* pref, int G) {
    const int tid = threadIdx.x, lane = tid & 63, wave = __builtin_amdgcn_readfirstlane(tid >> 6);
    const float* g1 = args.in[11]; const float* b1 = args.in[12]; const float* g2 = args.in[20]; const float* b2 = args.in[21];
    const bf16_t* Z = (const bf16_t*)(ws + WS_Z); const bf16_t* C = (const bf16_t*)(ws + WS_PROJ); const float2* PS = (const float2*)(ws + WS_PSTATS); const int* TOKSLOT = (const int*)(ws + WS_TOKSLOT);
    float* out = args.out;
    f32x4 G1[4], B1[4], G2[4], B2[4];
#pragma unroll
    for (int j = 0; j < 4; ++j) { const int c = 4 * lane + 256 * j; G1[j] = *(const f32x4*)(g1 + c); B1[j] = *(const f32x4*)(b1 + c); G2[j] = *(const f32x4*)(g2 + c); B2[j] = *(const f32x4*)(b2 + c); }
    for (int t = (int)blockIdx.x * NWAVES + wave; t < T; t += G * NWAVES) {
        const float2 ps = PS[(size_t)t * 16 + (lane & 15)];
        float s = ps.x, q = ps.y;
#pragma unroll
        for (int o = 1; o < 16; o <<= 1) { s += __shfl_xor(s, o); q += __shfl_xor(q, o); }
        const float mu = s * (1.f / D), rstd = 1.f / sqrtf(fmaxf(q * (1.f / D) - mu * mu, 0.f) + LN_EPS);
        const int s1 = TOKSLOT[t * 2], s2 = TOKSLOT[t * 2 + 1];
        const size_t r1 = (size_t)pref[s1 >> 15] * 256 + (s1 & (T - 1)), r2 = (size_t)pref[s2 >> 15] * 256 + (s2 & (T - 1));
        f32x4 v[4]; float sum = 0.f;
#pragma unroll
        for (int j = 0; j < 4; ++j) { const int c = 4 * lane + 256 * j;
            const uint2 zz = *(const uint2*)(Z + (size_t)t * D + c), c1 = *(const uint2*)(C + r1 * D + c), c2 = *(const uint2*)(C + r2 * D + c);
            f32x4 zf = {bf2f(zz.x), bf2f(zz.x >> 16), bf2f(zz.y), bf2f(zz.y >> 16)};
            f32x4 cf = {bf2f(c1.x) + bf2f(c2.x), bf2f(c1.x >> 16) + bf2f(c2.x >> 16), bf2f(c1.y) + bf2f(c2.y), bf2f(c1.y >> 16) + bf2f(c2.y >> 16)};
            v[j] = ALPHA * ((zf - mu) * rstd * G1[j] + B1[j]) + cf; sum += (v[j].x + v[j].y) + (v[j].z + v[j].w); }
        const float m2 = wave_sum(sum) * (1.f / D); float qq = 0.f;
#pragma unroll
        for (int j = 0; j < 4; ++j) { v[j] = v[j] - m2; qq += (v[j].x * v[j].x + v[j].y * v[j].y) + (v[j].z * v[j].z + v[j].w * v[j].w); }
        const float r2s = 1.f / sqrtf(wave_sum(qq) * (1.f / D) + LN_EPS);
#pragma unroll
        for (int j = 0; j < 4; ++j) *(f32x4*)(out + (size_t)t * D + 4 * lane + 256 * j) = v[j] * r2s * G2[j] + B2[j];
    }
}

__global__ void __launch_bounds__(NWAVES * 64, 2) mk_fwd(Args args) {
    extern __shared__ __attribute__((aligned(16))) unsigned char lds_raw[];
    LAS unsigned char* lds = (LAS unsigned char*)lds_raw;
    volatile LAS unsigned* MISC = (volatile LAS unsigned*)(lds + MISC_OFF);
    const int tid = threadIdx.x;
    const int G = gridDim.x;
    unsigned char* ws = args.ws;
    unsigned* ctl = (unsigned*)(ws + WS_CTL);
    float* vec = (float*)(ws + WS_VEC);
    bf16_t* WIN = (bf16_t*)(ws + WS_WIN); bf16_t* WOUT = (bf16_t*)(ws + WS_WOUT); bf16_t* WGU = (bf16_t*)(ws + WS_WGU); bf16_t* WD = (bf16_t*)(ws + WS_WD);
    bf16_t* XB = (bf16_t*)(ws + WS_XB); bf16_t* PROJ = (bf16_t*)(ws + WS_PROJ); bf16_t* CONTRIB = (bf16_t*)(ws + WS_PROJ);
    bf16_t* Y = (bf16_t*)(ws + WS_Y); bf16_t* Z = (bf16_t*)(ws + WS_Z); bf16_t* HID = (bf16_t*)(ws + WS_HID);
    float4* SLOT = (float4*)(ws + WS_SLOT); float2* PS = (float2*)(ws + WS_PSTATS);
    for (int u = tid; u < (LDS_BYTES - LDSCTL_OFF) / 4; u += NWAVES * 64) ((LAS unsigned*)(lds + LDSCTL_OFF))[u] = 0u;
    __syncthreads();
    XcdBarrier bar = xcd_barrier_post(ctl + CW_BAR + args.li * XCD_BAR_WORDS, MISC + 8);
    const int lo = args.ph_lo, hi = args.ph_hi;
#define IN(k) (lo <= (k) && (k) < hi)
#define BOTH(k) (IN(k) && IN((k) + 1))
#define GRID_BAR() xcd_barrier(bar)

    if (IN(0)) { p0_prologue(args, ws, lds, G); if (BOTH(0)) GRID_BAR(); }
    if (IN(1)) {
        pg8::StaticOrder S; S.init(T, NPROJ, G, (int)blockIdx.x);
        pg8::EpiBf16 E{PROJ, NPROJ, 0xffff};
        pg8::gemm_phase<pg8::EpiBf16, pg8::StaticOrder, pg8::DenseA, true>(lds + RING_OFF, XB, WIN, D, S, E, pg8::DenseA{});
        if (BOTH(1)) GRID_BAR();
    }
#if MK_MIX_SIMPLE
    if (IN(2)) { p2_mixer_simple(args, ws, lds, G); if (BOTH(2)) GRID_BAR(); }
#else
    if (IN(2)) { p2_mixer(args, ws, lds, G); if (BOTH(2)) GRID_BAR(); }
#endif
    if (IN(3)) {
        pg8::StaticOrder S; S.init(T, D, G, (int)blockIdx.x);
        pg8::EpiZ E{XB, Z, PS};
        pg8::gemm_phase<pg8::EpiZ, pg8::StaticOrder, pg8::DenseA, true>(lds + RING_OFF, Y, WOUT, D, S, E, pg8::DenseA{});
        if (BOTH(3)) GRID_BAR();
    }
    if (IN(4)) {
        float* LG = (float*)(ws + WS_HID);
        pg8::StaticOrder S; S.init(T, 256, G, (int)blockIdx.x);
        pg8::EpiLogits E{LG};
        pg8::gemm_phase<pg8::EpiLogits, pg8::StaticOrder, pg8::DenseA, true>(lds + RING_OFF, Z, (const bf16_t*)(ws + WS_WR), D, S, E, pg8::DenseA{});
        pg8::Unit u;
        if (S.next(0, u)) {
            VM_WAIT(); __syncthreads();
            __builtin_amdgcn_fence(__ATOMIC_ACQUIRE, "agent"); VM_WAIT();
            p4_route_tile(u.pm, LG, PS, vec + V_SR, vec + V_TR, ctl + CW_CNT, SLOT, (int*)(ws + WS_TOKSLOT), MISC);
        }
        if (BOTH(4)) GRID_BAR();
    }
    if (IN(5) || IN(6) || IN(7)) {
        if (tid < 32) MISC[64 + tid] = ctl[CW_CNT + tid];
        __syncthreads();
        if (tid == 0) { int s = 0; for (int e = 0; e < NE; ++e) { MISC[16 + e] = (unsigned)s; s += ((int)MISC[64 + e] + 255) / 256; } MISC[16 + NE] = (unsigned)s; }
        __syncthreads();
        const LAS int* pref = (const LAS int*)(lds + MISC_OFF) + 16; const LAS int* cntl = (const LAS int*)(lds + MISC_OFF) + 64;
        const int ntiles = pref[NE];
        if (IN(5)) {
            pg8::MoeOrder S{pref, 2, ntiles * 2, G, (int)blockIdx.x};
            LAS int* toks = (LAS int*)(lds + MISC_OFF + 1024);
            { pg8::Unit u; for (int i = 0; i < 4 && S.next(i, u); ++i) { if (tid < 256) { const int pos = u.tl * 256 + tid; toks[i * 256 + tid] = pos < cntl[u.e] ? __builtin_bit_cast(int, SLOT[(size_t)u.e * T + pos].x) : 0; } } }
            __syncthreads();
            pg8::EpiGU E{SLOT, vec + V_SGU, vec + V_TGU, HID};
            pg8::GatherA AS{toks};
            pg8::gemm_phase<pg8::EpiGU, pg8::MoeOrder, pg8::GatherA, true>(lds + RING_OFF, Z, WGU, D, S, E, AS);
            if (BOTH(5)) GRID_BAR();
        }
        if (IN(6)) {
            pg8::MoeOrder S{pref, 4, ntiles * 4, G, (int)blockIdx.x};
            pg8::EpiBf16 E{CONTRIB, D, 3};
            pg8::gemm_phase<pg8::EpiBf16, pg8::MoeOrder, pg8::DenseA, true>(lds + RING_OFF, HID, WD, DE, S, E, pg8::DenseA{});
            if (BOTH(6)) GRID_BAR();
        }
        if (IN(7)) p7_final(args, ws, pref, G);
    }
#undef IN
#undef BOTH
#undef GRID_BAR
}

static int mk_grid() {
    static int grid = 0;
    if (grid == 0) {
        int dev = 0, cus = 0;
        if (hipGetDevice(&dev) != hipSuccess || hipDeviceGetAttribute(&cus, hipDeviceAttributeMultiprocessorCount, dev) != hipSuccess) { grid = -1; return grid; }
        if (hipFuncSetAttribute((const void*)mk_fwd, hipFuncAttributeMaxDynamicSharedMemorySize, LDS_BYTES) != hipSuccess) { grid = -1; return grid; }
        int per_cu = 0;
        if (hipOccupancyMaxActiveBlocksPerMultiprocessor(&per_cu, (const void*)mk_fwd, NWAVES * 64, LDS_BYTES) != hipSuccess || per_cu < 1) { (void)hipGetLastError(); grid = -1; return grid; }
        grid = cus;
    }
    return grid;
}
static int g_li = 0;
static void mk_launch(const Args& base, int lo, int hi, hipStream_t stream) {
    const int grid = mk_grid(); if (grid <= 0) return;
    Args a = base; a.ph_lo = lo; a.ph_hi = hi; a.li = g_li++;
    hipLaunchKernelGGL(mk_fwd, dim3(grid), dim3(NWAVES * 64), LDS_BYTES, stream, a);
}

extern "C" void kernel_launch(void* const* d_in, const int* in_sizes, int n_in, void* d_out, int out_size, void* d_ws, size_t ws_size, hipStream_t stream) {
    if (ws_size < WS_END || n_in != 22) return;
    const float* x = (const float*)d_in[0]; const float* w_in = (const float*)d_in[1]; const float* rg_cw = (const float*)d_in[2]; const float* rg_cb = (const float*)d_in[3];
    const float* Wa = (const float*)d_in[4]; const float* ba = (const float*)d_in[5]; const float* Wx = (const float*)d_in[6]; const float* bx = (const float*)d_in[7];
    const float* lam = (const float*)d_in[8]; const float* sc_cw = (const float*)d_in[9]; const float* w_out = (const float*)d_in[10]; const float* g1 = (const float*)d_in[11]; const float* b1 = (const float*)d_in[12];
    const float* rgw = (const float*)d_in[13]; const float* rgb = (const float*)d_in[14]; const float* rew = (const float*)d_in[15]; const float* reb = (const float*)d_in[16];
    const float* wg = (const float*)d_in[17]; const float* wu = (const float*)d_in[18]; const float* wd = (const float*)d_in[19]; const float* g2 = (const float*)d_in[20]; const float* b2 = (const float*)d_in[21];
    char* ws = (char*)d_ws;
    int* cnt = (int*)(ws + WS_CTL); float* vec = (float*)(ws + WS_VEC); int* base = (int*)(vec + V_BASE);
    bf16_t* WIN = (bf16_t*)(ws + WS_WIN); bf16_t* WOUT = (bf16_t*)(ws + WS_WOUT); bf16_t* WR = (bf16_t*)(ws + WS_WR); bf16_t* WGU = (bf16_t*)(ws + WS_WGU); bf16_t* WD = (bf16_t*)(ws + WS_WD);
    bf16_t* XB = (bf16_t*)(ws + WS_XB); bf16_t* PROJ = (bf16_t*)(ws + WS_PROJ); float* GU = (float*)(ws + WS_PROJ); bf16_t* CONTRIB = (bf16_t*)(ws + WS_PROJ);
    bf16_t* Y = (bf16_t*)(ws + WS_Y); bf16_t* Z = (bf16_t*)(ws + WS_Z); bf16_t* HID = (bf16_t*)(ws + WS_HID);
    float4* SLOT = (float4*)(ws + WS_SLOT); int* TOKSLOT = (int*)(ws + WS_TOKSLOT); float2* PS = (float2*)(ws + WS_PSTATS);
    (void)GU; (void)PROJ; (void)CONTRIB; (void)HID; (void)XB; (void)WGU; (void)WD; (void)WIN; (void)WOUT;
    Args a{}; for (int i = 0; i < 22; ++i) a.in[i] = (const float*)d_in[i]; a.out = (float*)d_out; a.ws = (unsigned char*)d_ws;
    g_li = 0;

    (void)hipMemsetAsync(ws + WS_CTL, 0, CTL_BYTES, stream);
#if MK_ALL
    mk_launch(a, 0, 8, stream);
    return;
#endif
#if MK_P0
    mk_launch(a, 0, 1, stream);
#else
    k_cvt_x<<<2048, 256, 0, stream>>>(x, XB, (size_t)T * D / 4);
    k_tconv<<<dim3(NPROJ / 32, D / 32, 1), dim3(32, 8), 0, stream>>>(w_in, D, NPROJ, 0, WIN, 0, nullptr, NPROJ, 0, 0);
    k_tconv<<<dim3(D / 32, D / 32, 1), dim3(32, 8), 0, stream>>>(w_out, D, D, 0, WOUT, 0, nullptr, D, 0, 0);
    k_zero16<<<256, 256, 0, stream>>>(WR, (size_t)256 * D);
    k_tconv<<<dim3(1, D / 32, 1), dim3(32, 8), 0, stream>>>(rew, D, 32, 0, WR, 0, g1, 32, 0, 4);
    k_foldvec<<<dim3(1, 1), 64, 0, stream>>>(rew, D, 32, 0, g1, b1, reb, vec + V_SR, vec + V_TR, 0, 32, 0, 4);
    k_foldvec<<<dim3(1, 1), 64, 0, stream>>>(rgw, D, 4, 0, g1, b1, rgb, vec + V_SR, vec + V_TR, 0, 4, 0, 0);
    k_tconv<<<dim3(DE / 32, D / 32, NE), dim3(32, 8), 0, stream>>>(wg, D, DE, (size_t)D * DE, WGU, (size_t)512 * D, g1, 128, 256, 0);
    k_tconv<<<dim3(DE / 32, D / 32, NE), dim3(32, 8), 0, stream>>>(wu, D, DE, (size_t)D * DE, WGU, (size_t)512 * D, g1, 128, 256, 128);
    k_foldvec<<<dim3(1, NE), 256, 0, stream>>>(wg, D, DE, (size_t)D * DE, g1, b1, nullptr, vec + V_SGU, vec + V_TGU, 512, 128, 256, 0);
    k_foldvec<<<dim3(1, NE), 256, 0, stream>>>(wu, D, DE, (size_t)D * DE, g1, b1, nullptr, vec + V_SGU, vec + V_TGU, 512, 128, 256, 128);
    k_tconv<<<dim3(D / 32, DE / 32, NE), dim3(32, 8), 0, stream>>>(wd, DE, D, (size_t)DE * D, WD, (size_t)D * DE, nullptr, D, 0, 0);
    k_sp<<<2, 256, 0, stream>>>(lam, vec + V_SP);
    k_tconv4<<<16, 256, 0, stream>>>(rgw, g1, WR);
#endif
#if MK_P1
    mk_launch(a, 1, 2, stream);
#else
    { FProj f{XB, WIN, PROJ, 0, 0}; k_ngemm<<<dim3(NPROJ / 64, T / 64), 256, 0, stream>>>(f); }
#endif
#if MK_P2
    mk_launch(a, 2, 3, stream);
#else
    k_mix_rg<<<NBATCH * 8, 64, 0, stream>>>(PROJ, rg_cw, rg_cb, Wa, ba, Wx, bx, vec + V_SP, Y);
    k_mix_sc<<<(unsigned)(((size_t)T * DRG + 255) / 256), 256, 0, stream>>>(PROJ, sc_cw, Y);
#endif
#if MK_P3
    mk_launch(a, 3, 4, stream);
#else
    { FOut f{Y, WOUT, XB, Z, 0, 0}; k_ngemm<<<dim3(D / 64, T / 64), 256, 0, stream>>>(f); }
    k_pstats<<<T * 16 / 256, 256, 0, stream>>>(Z, PS);
#endif
#if MK_P4
    mk_launch(a, 4, 5, stream);
#else
    k_router<<<T, 64, 0, stream>>>(Z, WR, PS, vec + V_SR, vec + V_TR, cnt, SLOT, TOKSLOT);
#endif
    k_base<<<1, 64, 0, stream>>>(cnt, base);
#if MK_P5
    mk_launch(a, 5, 6, stream);
#else
    { FGateUp f{Z, WGU, SLOT, cnt, base, vec + V_SGU, vec + V_TGU, GU, 0, 0, 0, 0}; k_ngemm<<<dim3(512 / 64, T / 64, NE), 256, 0, stream>>>(f); }
    k_hid<<<dim3(1, T, NE), 256, 0, stream>>>(GU, SLOT, cnt, base, HID);
#endif
#if MK_P6
    mk_launch(a, 6, 7, stream);
#else
    { FDown f{HID, WD, cnt, base, CONTRIB, 0, 0, 0, 0}; k_ngemm<<<dim3(D / 64, T / 64, NE), 256, 0, stream>>>(f); }
#endif
#if MK_P7
    mk_launch(a, 7, 8, stream);
#else
    k_final<<<T, 64, 0, stream>>>(Z, PS, TOKSLOT, base, CONTRIB, g1, b1, g2, b2, (float*)d_out);
#endif
}
```

```cpp
#include <hip/hip_runtime.h>
#include <stdint.h>
#include <math.h>
#define MK_ALL 1
#define MK_MIX_SIMPLE 0
#define MK_P0 1
#define MK_P1 1
#define MK_P2 1
#define MK_P3 1
#define MK_P4 1
#define MK_P5 1
#define MK_P6 1
#define MK_P7 1

typedef unsigned short bf16_t;
typedef float f32x4 __attribute__((ext_vector_type(4)));

constexpr int T = 32768, D = 1024, SEQ = 2048, NBATCH = 16;
constexpr int DRG = 512, NPROJ = 2560, NE = 32, DE = 256, NGRP = 4, EPG = 8;
constexpr float LN_EPS = 1e-5f;
constexpr float ALPHA = 1.189207115002721f;
constexpr int SLOT_ROWS = 2 * T + NE * 256;

constexpr size_t MiB = 1u << 20;
constexpr size_t WS_CTL = 0;
constexpr size_t CTL_BYTES = 1 * MiB;
constexpr size_t WS_VEC = 1 * MiB;
constexpr size_t WS_WIN = 2 * MiB;
constexpr size_t WS_WOUT = 7 * MiB;
constexpr size_t WS_WR = 9 * MiB;
constexpr size_t WS_WGU = 10 * MiB;
constexpr size_t WS_WD = 42 * MiB;
constexpr size_t WS_XB = 60 * MiB;
constexpr size_t WS_PROJ = 124 * MiB;
constexpr size_t WS_Y = 284 * MiB;
constexpr size_t WS_Z = 348 * MiB;
constexpr size_t WS_HID = 412 * MiB;
constexpr size_t WS_SLOT = 448 * MiB;
constexpr size_t WS_TOKSLOT = 464 * MiB;
constexpr size_t WS_PSTATS = 465 * MiB;
constexpr size_t WS_PART = 470 * MiB;
constexpr size_t WS_END = 473 * MiB;
constexpr int NVF = NE * 512 + 64;

constexpr int V_SR = 0, V_TR = 256, V_SGU = 512, V_TGU = V_SGU + NE * 512, V_SP = V_TGU + NE * 512, V_BASE = V_SP + 512;

__device__ __forceinline__ unsigned f2bf(float f) { unsigned u = __builtin_bit_cast(unsigned, f); return (u + 0x7fffu + ((u >> 16) & 1u)) >> 16; }
__device__ __forceinline__ float bf2f(unsigned h) { return __builtin_bit_cast(float, (h & 0xffffu) << 16); }
__device__ __forceinline__ float sigmoidf_(float x) { return 1.f / (1.f + __expf(-x)); }
__device__ __forceinline__ float gelu_tanh(float x) { const float u = 0.7978845608028654f * (x + 0.044715f * x * x * x); return 0.5f * x * (1.f + tanhf(u)); }

__global__ void k_cvt_x(const float* __restrict__ x, bf16_t* __restrict__ xb, size_t n4) {
    for (size_t i = blockIdx.x * (size_t)blockDim.x + threadIdx.x; i < n4; i += (size_t)gridDim.x * blockDim.x) {
        const f32x4 v = ((const f32x4*)x)[i];
        uint2 o; o.x = f2bf(v.x) | (f2bf(v.y) << 16); o.y = f2bf(v.z) | (f2bf(v.w) << 16);
        ((uint2*)xb)[i] = o;
    }
}
__global__ void k_tconv(const float* __restrict__ W, int K, int N, size_t wbs, bf16_t* __restrict__ WT, size_t tbs, const float* __restrict__ scale, int blk, int stride, int off) {
    __shared__ float tile[32][33];
    const int e = blockIdx.z; W += e * wbs; WT += e * tbs;
    const int n0 = blockIdx.x * 32, k0 = blockIdx.y * 32, tx = threadIdx.x, ty = threadIdx.y;
    for (int j = ty; j < 32; j += 8) { const int k = k0 + j, n = n0 + tx; tile[j][tx] = (scale ? scale[k] : 1.f) * W[(size_t)k * N + n]; }
    __syncthreads();
    for (int j = ty; j < 32; j += 8) { const int n = n0 + j, k = k0 + tx; const int dr = (n / blk) * stride + off + n % blk; WT[(size_t)dr * K + k] = (bf16_t)f2bf(tile[tx][j]); }
}
__global__ void k_zero16(bf16_t* p, size_t n) { for (size_t i = blockIdx.x * (size_t)blockDim.x + threadIdx.x; i < n; i += (size_t)gridDim.x * blockDim.x) p[i] = 0; }
__global__ void k_foldvec(const float* __restrict__ W, int K, int N, size_t wbs, const float* __restrict__ g, const float* __restrict__ b, const float* __restrict__ bias,
                          float* __restrict__ S, float* __restrict__ Tv, size_t vbs, int blk, int stride, int off) {
    const int e = blockIdx.y; W += e * wbs; S += e * vbs; Tv += e * vbs;
    const int n = blockIdx.x * blockDim.x + threadIdx.x; if (n >= N) return;
    float s = 0.f, t = 0.f;
    for (int k = 0; k < K; ++k) { const float w = W[(size_t)k * N + n]; s += g[k] * w; t += b[k] * w; }
    const int dr = (n / blk) * stride + off + n % blk;
    S[dr] = s; Tv[dr] = t + (bias ? bias[n] : 0.f);
}
__global__ void k_sp(const float* __restrict__ lam, float* __restrict__ sp) { const int c = threadIdx.x + blockIdx.x * blockDim.x; if (c < DRG) sp[c] = 8.0f * log1pf(expf(-lam[c])); }

template <class F> __global__ void __launch_bounds__(256) k_ngemm(F f) {
    __shared__ float As[64][33], Bs[64][33];
    if (!f.setup()) return;
    const int tid = threadIdx.x, tx = tid & 15, ty = tid >> 4;
    const int lr = tid >> 2, lk = (tid & 3) * 8;
    const bf16_t* ap = f.arow(lr); const bf16_t* bp = f.brow(lr);
    float acc[4][4] = {};
    const int K = f.K();
    for (int k0 = 0; k0 < K; k0 += 32) {
        uint4 av = make_uint4(0, 0, 0, 0), bv = make_uint4(0, 0, 0, 0);
        if (ap) av = *(const uint4*)(ap + k0 + lk);
        if (bp) bv = *(const uint4*)(bp + k0 + lk);
        const unsigned aw[4] = {av.x, av.y, av.z, av.w}, bw[4] = {bv.x, bv.y, bv.z, bv.w};
#pragma unroll
        for (int j = 0; j < 4; ++j) { As[lr][lk + 2 * j] = bf2f(aw[j]); As[lr][lk + 2 * j + 1] = bf2f(aw[j] >> 16); Bs[lr][lk + 2 * j] = bf2f(bw[j]); Bs[lr][lk + 2 * j + 1] = bf2f(bw[j] >> 16); }
        __syncthreads();
#pragma unroll 8
        for (int k = 0; k < 32; ++k) {
            float a[4], b[4];
#pragma unroll
            for (int i = 0; i < 4; ++i) { a[i] = As[ty * 4 + i][k]; b[i] = Bs[tx * 4 + i][k]; }
#pragma unroll
            for (int i = 0; i < 4; ++i)
#pragma unroll
                for (int j = 0; j < 4; ++j) acc[i][j] += a[i] * b[j];
        }
        __syncthreads();
    }
#pragma unroll
    for (int i = 0; i < 4; ++i)
#pragma unroll
        for (int j = 0; j < 4; ++j) f.out(ty * 4 + i, tx * 4 + j, acc[i][j]);
}

struct FProj {
    const bf16_t* A; const bf16_t* Bt; bf16_t* O; int r0, c0;
    __device__ bool setup() { r0 = blockIdx.y * 64; c0 = blockIdx.x * 64; return true; }
    __device__ const bf16_t* arow(int r) const { return A + (size_t)(r0 + r) * D; }
    __device__ const bf16_t* brow(int c) const { return Bt + (size_t)(c0 + c) * D; }
    __device__ int K() const { return D; }
    __device__ void out(int r, int c, float v) const { O[(size_t)(r0 + r) * NPROJ + c0 + c] = (bf16_t)f2bf(v); }
};
struct FOut {
    const bf16_t* A; const bf16_t* Bt; const bf16_t* XB; bf16_t* Z; int r0, c0;
    __device__ bool setup() { r0 = blockIdx.y * 64; c0 = blockIdx.x * 64; return true; }
    __device__ const bf16_t* arow(int r) const { return A + (size_t)(r0 + r) * D; }
    __device__ const bf16_t* brow(int c) const { return Bt + (size_t)(c0 + c) * D; }
    __device__ int K() const { return D; }
    __device__ void out(int r, int c, float v) const { const size_t i = (size_t)(r0 + r) * D + c0 + c; Z[i] = (bf16_t)f2bf(ALPHA * bf2f(XB[i]) + v); }
};
struct FGateUp {
    const bf16_t* Z; const bf16_t* WGU; const float4* SLOT; const int* cnt; const int* base; const float* SGU; const float* TGU; float* GU; int e, p0, c0, ne;
    __device__ bool setup() { e = blockIdx.z; ne = cnt[e]; p0 = blockIdx.y * 64; c0 = blockIdx.x * 64; return p0 < ne; }
    __device__ const bf16_t* arow(int r) const { const int pos = p0 + r; if (pos >= ne) return nullptr; const int tok = __builtin_bit_cast(int, SLOT[(size_t)e * T + pos].x); return Z + (size_t)tok * D; }
    __device__ const bf16_t* brow(int c) const { return WGU + ((size_t)e * 512 + c0 + c) * D; }
    __device__ int K() const { return D; }
    __device__ void out(int r, int c, float v) const { const int pos = p0 + r; if (pos >= ne) return; const float4 si = SLOT[(size_t)e * T + pos];
        const int n = c0 + c; GU[(size_t)(base[e] + pos) * 512 + n] = si.y * (v - si.z * SGU[e * 512 + n]) + TGU[e * 512 + n]; }
};
struct FDown {
    const bf16_t* HID; const bf16_t* WD; const int* cnt; const int* base; bf16_t* C; int e, p0, c0, ne;
    __device__ bool setup() { e = blockIdx.z; ne = cnt[e]; p0 = blockIdx.y * 64; c0 = blockIdx.x * 64; return p0 < ne; }
    __device__ const bf16_t* arow(int r) const { const int pos = p0 + r; if (pos >= ne) return nullptr; return HID + (size_t)(base[e] + pos) * DE; }
    __device__ const bf16_t* brow(int c) const { return WD + ((size_t)e * D + c0 + c) * DE; }
    __device__ int K() const { return DE; }
    __device__ void out(int r, int c, float v) const { const int pos = p0 + r; if (pos >= ne) return; C[(size_t)(base[e] + pos) * D + c0 + c] = (bf16_t)f2bf(v); }
};

__global__ void __launch_bounds__(64) k_mix_rg(const bf16_t* __restrict__ PROJ, const float* __restrict__ cw, const float* __restrict__ cb, const float* __restrict__ Wa, const float* __restrict__ ba,
                                               const float* __restrict__ Wx, const float* __restrict__ bx, const float* __restrict__ sp, bf16_t* __restrict__ Y) {
    __shared__ float wa[64][64], wx[64][64], xs[64];
    const int b = blockIdx.x >> 3, h = blockIdx.x & 7, lane = threadIdx.x, c = h * 64 + lane;
    for (int i = 0; i < 64; ++i) { wa[i][lane] = Wa[(h * 64 + i) * 64 + lane]; wx[i][lane] = Wx[(h * 64 + i) * 64 + lane]; }
    const float w0 = cw[0 * DRG + c], w1 = cw[1 * DRG + c], w2 = cw[2 * DRG + c], w3 = cw[3 * DRG + c], cbias = cb[c], bac = ba[c], bxc = bx[c], spc = sp[c];
    float x0 = 0.f, x1 = 0.f, x2 = 0.f, hs = 0.f;
    __syncthreads();
    for (int t = 0; t < SEQ; ++t) {
        const size_t row = (size_t)b * SEQ + t;
        const float x3 = bf2f(PROJ[row * NPROJ + c]);
        const float xc = cbias + w0 * x0 + w1 * x1 + w2 * x2 + w3 * x3;
        x0 = x1; x1 = x2; x2 = x3;
        xs[lane] = xc;
        __syncthreads();
        float ra = bac, rx = bxc;
#pragma unroll 8
        for (int i = 0; i < 64; ++i) { const float v = xs[i]; ra += v * wa[i][lane]; rx += v * wx[i][lane]; }
        const float r = sigmoidf_(ra), ii = sigmoidf_(rx);
        const float la = -spc * r, a = expf(la), mult = sqrtf(-expm1f(2.f * la));
        hs = a * hs + mult * (ii * xc);
        const float gate = bf2f(PROJ[row * NPROJ + DRG + c]);
        Y[row * D + c] = (bf16_t)f2bf(hs * gelu_tanh(gate));
        __syncthreads();
    }
}
__global__ void k_mix_sc(const bf16_t* __restrict__ PROJ, const float* __restrict__ scw, bf16_t* __restrict__ Y) {
    const size_t i = blockIdx.x * (size_t)blockDim.x + threadIdx.x; if (i >= (size_t)T * DRG) return;
    const int c = (int)(i % DRG); const size_t row = i / DRG; const int t = (int)(row % SEQ);
    float s = 0.f;
#pragma unroll
    for (int k = 0; k < 3; ++k) { const int tt = t - 2 + k; if (tt >= 0) { const size_t r2 = row - 2 + k; s += scw[k * DRG + c] * (bf2f(PROJ[r2 * NPROJ + 1536 + c]) * bf2f(PROJ[r2 * NPROJ + 2048 + c])); } }
    Y[row * D + DRG + c] = (bf16_t)f2bf(bf2f(PROJ[row * NPROJ + 1024 + c]) * s);
}
__global__ void k_pstats(const bf16_t* __restrict__ Z, float2* __restrict__ PS) {
    const size_t i = blockIdx.x * (size_t)blockDim.x + threadIdx.x; if (i >= (size_t)T * 16) return;
    const int pn = (int)((i >> 2) & 3), wc = (int)(i & 3);
    const bf16_t* p = Z + (i >> 4) * D + pn * 256 + wc * 32; float s = 0.f, q = 0.f;
    for (int bj = 0; bj < 2; ++bj) for (int k = 0; k < 32; ++k) { const float v = bf2f(p[bj * 128 + k]); s += v; q += v * v; }
    PS[i] = make_float2(s, q);
}
__device__ __forceinline__ void row_stats(const float2* PS, int t, float& mu, float& rstd) {
    float s = 0.f, q = 0.f;
#pragma unroll
    for (int j = 0; j < 16; ++j) { const float2 a = PS[(size_t)t * 16 + j]; s += a.x; q += a.y; }
    mu = s * (1.f / D); const float var = q * (1.f / D) - mu * mu; rstd = 1.f / sqrtf(fmaxf(var, 0.f) + LN_EPS);
}
__global__ void __launch_bounds__(64) k_router(const bf16_t* __restrict__ Z, const bf16_t* __restrict__ WR, const float2* __restrict__ PS, const float* __restrict__ SR, const float* __restrict__ TR,
                                               int* __restrict__ cnt, float4* __restrict__ SLOT, int* __restrict__ TOKSLOT) {
    __shared__ float lg[64];
    const int t = blockIdx.x, lane = threadIdx.x;
    float mu, rstd; row_stats(PS, t, mu, rstd);
    if (lane < 36) { float s = 0.f; const bf16_t* z = Z + (size_t)t * D; const bf16_t* w = WR + (size_t)lane * D;
        for (int k = 0; k < D; ++k) s += bf2f(z[k]) * bf2f(w[k]);
        lg[lane] = rstd * (s - mu * SR[lane]) + TR[lane]; }
    __syncthreads();
    if (lane == 0) {
        int g = 0; float gm = lg[0];
        for (int j = 1; j < NGRP; ++j) if (lg[j] > gm) { gm = lg[j]; g = j; }
        float den = 0.f; for (int j = 0; j < NGRP; ++j) den += expf(lg[j] - gm);
        const float gp = 1.f / den;
        const float* el = lg + 4 + g * EPG;
        int i1 = 0; float v1 = el[0];
        for (int j = 1; j < EPG; ++j) if (el[j] > v1) { v1 = el[j]; i1 = j; }
        int i2 = -1; float v2 = -INFINITY;
        for (int j = 0; j < EPG; ++j) if (j != i1 && el[j] > v2) { v2 = el[j]; i2 = j; }
        const float e2 = expf(v2 - v1), w1 = gp / (1.f + e2), w2 = gp * e2 / (1.f + e2);
        const int ea = g * EPG + i1, eb = g * EPG + i2;
        const int pa = atomicAdd(&cnt[ea], 1), pb = atomicAdd(&cnt[eb], 1);
        SLOT[(size_t)ea * T + pa] = make_float4(__builtin_bit_cast(float, t), rstd, mu, w1);
        SLOT[(size_t)eb * T + pb] = make_float4(__builtin_bit_cast(float, t), rstd, mu, w2);
        TOKSLOT[t * 2 + 0] = ea * T + pa; TOKSLOT[t * 2 + 1] = eb * T + pb;
    }
}
__global__ void k_base(const int* __restrict__ cnt, int* __restrict__ base) { if (threadIdx.x == 0) { int s = 0; for (int e = 0; e < NE; ++e) { base[e] = s; s += (cnt[e] + 255) / 256 * 256; } base[NE] = s; } }
__global__ void k_hid(const float* __restrict__ GU, const float4* __restrict__ SLOT, const int* __restrict__ cnt, const int* __restrict__ base, bf16_t* __restrict__ HID) {
    const int e = blockIdx.z, pos = blockIdx.y, f = threadIdx.x; if (pos >= cnt[e]) return;
    const size_t row = (size_t)base[e] + pos; const int j = f >> 7, fl = f & 127;
    const float g = GU[row * 512 + 256 * j + fl], u = GU[row * 512 + 256 * j + 128 + fl], cw = SLOT[(size_t)e * T + pos].w;
    HID[row * DE + f] = (bf16_t)f2bf(g * sigmoidf_(g) * u * cw);
}
__global__ void __launch_bounds__(64) k_final(const bf16_t* __restrict__ Z, const float2* __restrict__ PS, const int* __restrict__ TOKSLOT, const int* __restrict__ base, const bf16_t* __restrict__ C,
                                              const float* __restrict__ g1, const float* __restrict__ b1, const float* __restrict__ g2, const float* __restrict__ b2, float* __restrict__ out) {
    const int t = blockIdx.x, lane = threadIdx.x;
    float mu, rstd; row_stats(PS, t, mu, rstd);
    const int s1 = TOKSLOT[t * 2], s2 = TOKSLOT[t * 2 + 1];
    const size_t r1 = (size_t)base[s1 / T] + s1 % T, r2 = (size_t)base[s2 / T] + s2 % T;
    float v[16]; float s = 0.f;
#pragma unroll
    for (int j = 0; j < 16; ++j) { const int c = j * 64 + lane; const float h1 = (bf2f(Z[(size_t)t * D + c]) - mu) * rstd * g1[c] + b1[c];
        v[j] = ALPHA * h1 + bf2f(C[r1 * D + c]) + bf2f(C[r2 * D + c]); s += v[j]; }
    for (int o = 1; o < 64; o <<= 1) s += __shfl_xor(s, o);
    const float m2 = s * (1.f / D); float q = 0.f;
#pragma unroll
    for (int j = 0; j < 16; ++j) { const float d = v[j] - m2; q += d * d; }
    for (int o = 1; o < 64; o <<= 1) q += __shfl_xor(q, o);
    const float r2s = 1.f / sqrtf(q * (1.f / D) + LN_EPS);
#pragma unroll
    for (int j = 0; j < 16; ++j) { const int c = j * 64 + lane; out[(size_t)t * D + c] = (v[j] - m2) * r2s * g2[c] + b2[c]; }
}

__global__ void k_tconv4(const float* __restrict__ W, const float* __restrict__ g, bf16_t* __restrict__ WT) {
    const int i = blockIdx.x * blockDim.x + threadIdx.x; if (i >= 4 * D) return; const int n = i / D, k = i % D; WT[(size_t)n * D + k] = (bf16_t)f2bf(g[k] * W[k * 4 + n]);
}


#define LAS __attribute__((address_space(3)))
#define GAS __attribute__((address_space(1)))
typedef short bf16x8 __attribute__((ext_vector_type(8)));
typedef unsigned u32x4 __attribute__((ext_vector_type(4)));
typedef float f32x2 __attribute__((ext_vector_type(2)));
namespace pg8 {
constexpr int BM = 256, BK = 64, HALF = 128, HTB = HALF * BK * 2, STAGE_BYTES = 8 * HTB, NXCD = 8, WGM = 8;
__host__ __device__ __forceinline__ int lds_byte(int r, int c) { const int st = (r >> 4) * 2 + (c >> 5), rr = r & 15, cc = c & 31, ob = rr * 64 + cc * 2; return st * 1024 + (ob ^ (((ob >> 9) & 1) << 5)); }
__host__ __device__ __forceinline__ void stage_rc(int b, int& R, int& C) { const int st = b / 1024, sb = b % 1024, swz = sb ^ (((sb >> 9) & 1) << 5); R = (st >> 1) * 16 + swz / 64; C = (st & 1) * 32 + (swz % 64) / 2; }
__host__ __device__ __forceinline__ int perm32(int rho) { const int n = rho >> 4, i = rho & 15; return 8 * (i >> 2) + 4 * n + (i & 3); }
__device__ __forceinline__ unsigned cvt_pk_bf16(float lo, float hi) { unsigned r; asm volatile("v_cvt_pk_bf16_f32 %0, %1, %2" : "=v"(r) : "v"(lo), "v"(hi)); return r; }

struct Unit { int pm, pn, e, tl; };

__device__ __forceinline__ int xcd_remap(int L, int nwg) { const int q = nwg / NXCD, r = nwg % NXCD, xcd = L % NXCD, off = L / NXCD; return (xcd < r ? xcd * (q + 1) : r * (q + 1) + (xcd - r) * q) + off; }
struct StaticOrder {
    int nM, nN, nwg, G, c;
    __device__ void init(int M, int N, int G_, int c_) { nM = M / BM; nN = N / BM; nwg = nM * nN; G = G_; c = c_; }
    __device__ bool next(int i, Unit& u) const {
        const long L = (long)i * G + c; if (L >= nwg) return false;
        const int wgid = xcd_remap((int)L, nwg);
        const int nig = WGM * nN, gid = wgid / nig, fm = gid * WGM, gsz = (nM - fm) < WGM ? (nM - fm) : WGM;
        u.pm = fm + ((wgid % nig) % gsz); u.pn = (wgid % nig) / gsz; u.e = 0; u.tl = 0; return true;
    }
};
struct MoeOrder {
    const LAS int* pref;
    int NP, nunits, G, c;
    __device__ bool next(int i, Unit& u) const {
        const long L = (long)i * G + c; if (L >= nunits) return false;
        const int wgid = xcd_remap((int)L, nunits);
        const int tg = wgid / NP, pl = wgid % NP;
        int e = 0; while (pref[e + 1] <= tg) ++e;
        e = __builtin_amdgcn_readfirstlane(e);
        u.pm = __builtin_amdgcn_readfirstlane(tg); u.e = e; u.tl = __builtin_amdgcn_readfirstlane(tg - pref[e]); u.pn = e * NP + pl; return true;
    }
};
struct DenseA { static constexpr bool GATHER = false; };
struct GatherA { static constexpr bool GATHER = true; const LAS int* toks; };

struct EpiBf16 {
    static constexpr bool PERM = true;
    bf16_t* O; int ldc; int cmask;
    __device__ __forceinline__ void operator()(const f32x4 (&acc)[2][2][4][2], const Unit& u, int wr, int wc, int fr, int fq) const {
        const int row0 = u.pm * BM + wr * 64 + fr, col0 = (u.pn & cmask) * BM + wc * 32 + 8 * fq;
#pragma unroll
        for (int ai = 0; ai < 2; ++ai)
#pragma unroll
            for (int m = 0; m < 4; ++m) { bf16_t* rowp = O + (size_t)(row0 + ai * HALF + m * 16) * ldc + col0;
#pragma unroll
                for (int bj = 0; bj < 2; ++bj) { const f32x4 v0 = acc[ai][bj][m][0], v1 = acc[ai][bj][m][1];
                    u32x4 w; w.x = cvt_pk_bf16(v0[0], v0[1]); w.y = cvt_pk_bf16(v0[2], v0[3]); w.z = cvt_pk_bf16(v1[0], v1[1]); w.w = cvt_pk_bf16(v1[2], v1[3]);
                    *(u32x4*)(rowp + bj * HALF) = w; } }
    }
};
struct EpiZ {
    static constexpr bool PERM = true;
    const bf16_t* XB; bf16_t* Z; float2* PS;
    __device__ __forceinline__ void operator()(const f32x4 (&acc)[2][2][4][2], const Unit& u, int wr, int wc, int fr, int fq) const {
        const int row0 = u.pm * BM + wr * 64 + fr, col0 = u.pn * BM + wc * 32 + 8 * fq;
#pragma unroll
        for (int ai = 0; ai < 2; ++ai)
#pragma unroll
            for (int m = 0; m < 4; ++m) { const int r = row0 + ai * HALF + m * 16; const size_t off = (size_t)r * D + col0; float s = 0.f, q = 0.f;
#pragma unroll
                for (int bj = 0; bj < 2; ++bj) { const u32x4 xv = *(const u32x4*)(XB + off + bj * HALF); const f32x4 v0 = acc[ai][bj][m][0], v1 = acc[ai][bj][m][1];
                    u32x4 w;
                    w.x = cvt_pk_bf16(ALPHA * bf2f(xv.x) + v0[0], ALPHA * bf2f(xv.x >> 16) + v0[1]); w.y = cvt_pk_bf16(ALPHA * bf2f(xv.y) + v0[2], ALPHA * bf2f(xv.y >> 16) + v0[3]);
                    w.z = cvt_pk_bf16(ALPHA * bf2f(xv.z) + v1[0], ALPHA * bf2f(xv.z >> 16) + v1[1]); w.w = cvt_pk_bf16(ALPHA * bf2f(xv.w) + v1[2], ALPHA * bf2f(xv.w >> 16) + v1[3]);
                    *(u32x4*)(Z + off + bj * HALF) = w;
                    const unsigned ww[4] = {w.x, w.y, w.z, w.w};
#pragma unroll
                    for (int k = 0; k < 4; ++k) { const float a = bf2f(ww[k]), b = bf2f(ww[k] >> 16); s += a + b; q += a * a + b * b; } }
                s += __shfl_xor(s, 16); s += __shfl_xor(s, 32); q += __shfl_xor(q, 16); q += __shfl_xor(q, 32);
                if (fq == 0) PS[(size_t)r * 16 + u.pn * 4 + wc] = make_float2(s, q); }
    }
};
struct EpiLogits {
    static constexpr bool PERM = true;
    float* LG;
    __device__ __forceinline__ void operator()(const f32x4 (&acc)[2][2][4][2], const Unit& u, int wr, int wc, int fr, int fq) const {
        if (wc >= 2) return;
        const int row0 = u.pm * BM + wr * 64 + fr, col0 = wc * 32 + 8 * fq;
#pragma unroll
        for (int ai = 0; ai < 2; ++ai)
#pragma unroll
            for (int m = 0; m < 4; ++m) { float* p = LG + (size_t)(row0 + ai * HALF + m * 16) * 64 + col0; *(f32x4*)p = acc[ai][0][m][0]; *(f32x4*)(p + 4) = acc[ai][0][m][1]; }
    }
};
struct EpiGU {
    static constexpr bool PERM = true;
    const float4* SLOT; const float* SGU; const float* TGU; bf16_t* HID;
    __device__ __forceinline__ void operator()(const f32x4 (&acc)[2][2][4][2], const Unit& u, int wr, int wc, int fr, int fq) const {
        const int e = u.e, j = u.pn & 1, fcol = wc * 32 + 8 * fq;
        const float* sgp = SGU + e * 512 + 256 * j + fcol; const float* tgp = TGU + e * 512 + 256 * j + fcol;
        const f32x4 sg0 = *(const f32x4*)(sgp), sg1 = *(const f32x4*)(sgp + 4), su0 = *(const f32x4*)(sgp + 128), su1 = *(const f32x4*)(sgp + 132);
        const f32x4 tg0 = *(const f32x4*)(tgp), tg1 = *(const f32x4*)(tgp + 4), tu0 = *(const f32x4*)(tgp + 128), tu1 = *(const f32x4*)(tgp + 132);
#pragma unroll
        for (int ai = 0; ai < 2; ++ai)
#pragma unroll
            for (int m = 0; m < 4; ++m) { const int rl = ai * HALF + wr * 64 + m * 16 + fr;
                const float4 si = SLOT[(size_t)e * T + u.tl * BM + rl]; const float rstd = si.y, rm = si.y * si.z, cw = si.w;
                float h[8];
#pragma unroll
                for (int n = 0; n < 2; ++n) { const f32x4 ag = acc[ai][0][m][n], au = acc[ai][1][m][n]; const f32x4 sg = n ? sg1 : sg0, su = n ? su1 : su0, tg = n ? tg1 : tg0, tu = n ? tu1 : tu0;
#pragma unroll
                    for (int k = 0; k < 4; ++k) { const float g = rstd * ag[k] - rm * sg[k] + tg[k], uu = rstd * au[k] - rm * su[k] + tu[k];
                        h[4 * n + k] = g * __builtin_amdgcn_rcpf(1.f + __expf(-g)) * uu * cw; } }
                u32x4 w; w.x = cvt_pk_bf16(h[0], h[1]); w.y = cvt_pk_bf16(h[2], h[3]); w.z = cvt_pk_bf16(h[4], h[5]); w.w = cvt_pk_bf16(h[6], h[7]);
                *(u32x4*)(HID + (size_t)(u.pm * BM + rl) * DE + 128 * j + fcol) = w; }
    }
};

template <class Epi, class Sched, class ASrc, bool ALIGN_EPI>
__device__ __forceinline__ void gemm_phase(LAS unsigned char* lds, const bf16_t* Ag, const bf16_t* Btg, const int K, const Sched& S, const Epi& E, const ASrc& AS) {
    const int tid = threadIdx.x, wid = __builtin_amdgcn_readfirstlane(tid >> 6), lane = tid & 63, wr = wid >> 2, wc = wid & 3, fr = lane & 15, fq = lane >> 4;
    const int nt = K / BK;
    unsigned voffA[2], voffB[2]; int RA[2], CA[2];
#pragma unroll
    for (int i = 0; i < 2; ++i) { int R, C; stage_rc(tid * 16 + i * 8192, R, C); const int Rb = Epi::PERM ? ((R & ~31) + perm32(R & 31)) : R; RA[i] = R; CA[i] = C;
        voffA[i] = (unsigned)(R * K + C) * 2u; voffB[i] = (unsigned)(Rb * K + C) * 2u; }
    const size_t kstep = (size_t)(BK * 2);
    const size_t hstep = (size_t)HALF * K * 2;
    const size_t tstep = 2 * hstep;
    const unsigned ldsw = (unsigned)wid * 1024u;
    const int aoff = lds_byte(wr * 64 + fr, fq * 8), boff = lds_byte(wc * 32 + fr, fq * 8);
#define PG8_SA(b, h) (((b) * 2 + (h)) * HTB)
#define PG8_SB(b, h) ((4 + (b) * 2 + (h)) * HTB)
#define PG8_STAGE(bufoff, gbase, voff) do { _Pragma("unroll") for (int _i = 0; _i < 2; ++_i) \
        __builtin_amdgcn_global_load_lds((const unsigned*)((const char*)(gbase) + (voff)[_i]), (LAS unsigned*)(lds + (bufoff) + ldsw + _i * 8192), 16, 0, 0); } while (0)
#define PG8_LDA(dst, b, h) do { _Pragma("unroll") for (int m = 0; m < 4; ++m) _Pragma("unroll") for (int k = 0; k < 2; ++k) dst[m][k] = *(const LAS bf16x8*)(lds + PG8_SA(b, h) + aoff + m * 2048 + k * 1024); } while (0)
#define PG8_LDB(dst, b, h) do { _Pragma("unroll") for (int n = 0; n < 2; ++n) _Pragma("unroll") for (int k = 0; k < 2; ++k) dst[n][k] = *(const LAS bf16x8*)(lds + PG8_SB(b, h) + boff + n * 2048 + k * 1024); } while (0)
#define PG8_MMA(ai, bj, At, Bt) do { __builtin_amdgcn_s_setprio(1); _Pragma("unroll") for (int m = 0; m < 4; ++m) _Pragma("unroll") for (int n = 0; n < 2; ++n) _Pragma("unroll") for (int k = 0; k < 2; ++k) \
        acc[ai][bj][m][n] = __builtin_amdgcn_mfma_f32_16x16x32_bf16(Bt[n][k], At[m][k], acc[ai][bj][m][n], 0, 0, 0); __builtin_amdgcn_s_setprio(0); } while (0)
#define PG8_WAIT_V(n) asm volatile("s_waitcnt vmcnt(" #n ")" ::: "memory")
#define PG8_WAIT_L(n) asm volatile("s_waitcnt lgkmcnt(" #n ")" ::: "memory")
#define PG8_BAR __builtin_amdgcn_s_barrier()
#define PG8_SCHED __builtin_amdgcn_sched_barrier(0)
#define PG8_GOFF(dst, uidx) do { if constexpr (ASrc::GATHER) { _Pragma("unroll") for (int _h = 0; _h < 2; ++_h) _Pragma("unroll") for (int _i = 0; _i < 2; ++_i) \
        dst[_h][_i] = (unsigned)(AS.toks[(uidx) * BM + _h * HALF + RA[_i]] * K + CA[_i]) * 2u; } } while (0)
#define PG8_AVO(h, nextc) (ASrc::GATHER ? ((nextc) ? nvo[h] : cvo[h]) : voffA)
    Unit cur, nxt; int ui = 0;
    if (!S.next(0, cur)) return;
    f32x4 acc[2][2][4][2];
#pragma unroll
    for (int a = 0; a < 2; ++a)
#pragma unroll
        for (int b = 0; b < 2; ++b)
#pragma unroll
            for (int m = 0; m < 4; ++m)
#pragma unroll
                for (int n = 0; n < 2; ++n) acc[a][b][m][n] = (f32x4){0.f, 0.f, 0.f, 0.f};
    bf16x8 At[4][2], B0[2][2], B1[2][2];
    unsigned cvo[2][2], nvo[2][2];
    if constexpr (ASrc::GATHER) { PG8_GOFF(cvo, 0);
#pragma unroll
        for (int h = 0; h < 2; ++h) { nvo[h][0] = cvo[h][0]; nvo[h][1] = cvo[h][1]; } }
    const char* cA0 = ASrc::GATHER ? (const char*)Ag : (const char*)Ag + (size_t)cur.pm * tstep; const char* cA1 = ASrc::GATHER ? cA0 : cA0 + hstep;
    const char* cB = (const char*)Btg + (size_t)cur.pn * tstep;
    PG8_STAGE(PG8_SB(0, 0), cB, voffB); PG8_STAGE(PG8_SB(0, 1), cB + hstep, voffB); PG8_STAGE(PG8_SA(0, 0), cA0, PG8_AVO(0, false)); PG8_STAGE(PG8_SA(0, 1), cA1, PG8_AVO(1, false));
    if (wr == 1) PG8_BAR;
    PG8_WAIT_V(2); PG8_BAR;
    PG8_STAGE(PG8_SB(1, 0), cB + kstep, voffB); PG8_STAGE(PG8_SA(1, 0), cA0 + kstep, PG8_AVO(0, false)); PG8_STAGE(PG8_SB(1, 1), cB + hstep + kstep, voffB);
    PG8_WAIT_V(6); PG8_BAR;
#define PG8_KBODY() do { \
            const bool last = (t == nt - 2); \
            const char* a1_1 = cA1 + (size_t)(t + 1) * kstep; \
            const char* a2_0 = last ? nA0 : cA0 + (size_t)(t + 2) * kstep; const char* a2_1 = last ? nA1 : cA1 + (size_t)(t + 2) * kstep; \
            const char* b2 = last ? nB : cB + (size_t)(t + 2) * kstep; const char* a3_0 = a2_0 + kstep; const char* b3 = b2 + kstep; \
            unsigned vs[2][2]; if constexpr (ASrc::GATHER) { _Pragma("unroll") for (int _h = 0; _h < 2; ++_h) _Pragma("unroll") for (int _i = 0; _i < 2; ++_i) vs[_h][_i] = last ? nvo[_h][_i] : cvo[_h][_i]; } \
            PG8_LDB(B0, 0, 0); PG8_LDB(B1, 0, 1); PG8_SCHED; PG8_LDA(At, 0, 0); PG8_STAGE(PG8_SA(1, 1), a1_1, PG8_AVO(1, false)); \
            PG8_WAIT_V(8); PG8_WAIT_L(0); PG8_BAR; PG8_MMA(0, 0, At, B0); PG8_MMA(0, 1, At, B1); PG8_BAR; PG8_SCHED; \
            PG8_LDA(At, 0, 1); PG8_STAGE(PG8_SB(0, 0), b2, voffB); PG8_STAGE(PG8_SB(0, 1), b2 + hstep, voffB); PG8_STAGE(PG8_SA(0, 0), a2_0, (ASrc::GATHER ? vs[0] : voffA)); \
            PG8_WAIT_V(8); PG8_WAIT_L(0); PG8_BAR; PG8_MMA(1, 0, At, B0); PG8_MMA(1, 1, At, B1); PG8_BAR; PG8_SCHED; \
            PG8_LDB(B0, 1, 0); PG8_LDB(B1, 1, 1); PG8_SCHED; PG8_LDA(At, 1, 0); PG8_STAGE(PG8_SA(0, 1), a2_1, (ASrc::GATHER ? vs[1] : voffA)); \
            PG8_WAIT_V(8); PG8_WAIT_L(0); PG8_BAR; PG8_MMA(0, 0, At, B0); PG8_MMA(0, 1, At, B1); PG8_BAR; PG8_SCHED; \
            PG8_LDA(At, 1, 1); PG8_STAGE(PG8_SB(1, 0), b3, voffB); PG8_STAGE(PG8_SB(1, 1), b3 + hstep, voffB); PG8_STAGE(PG8_SA(1, 0), a3_0, (ASrc::GATHER ? vs[0] : voffA)); \
            PG8_WAIT_V(8); PG8_WAIT_L(0); PG8_BAR; PG8_MMA(1, 0, At, B0); PG8_MMA(1, 1, At, B1); PG8_BAR; PG8_SCHED; } while (0)
    for (;;) {
        const bool has_next = S.next(ui + 1, nxt);
        const char* nA0 = cA0; const char* nA1 = cA1; const char* nB = cB;
        if (has_next) { nA0 = ASrc::GATHER ? (const char*)Ag : (const char*)Ag + (size_t)nxt.pm * tstep; nA1 = ASrc::GATHER ? nA0 : nA0 + hstep; nB = (const char*)Btg + (size_t)nxt.pn * tstep;
            if constexpr (ASrc::GATHER) { PG8_GOFF(nvo, ui + 1); } }
#pragma nounroll
        for (int t = 0; t < nt; t += 2) PG8_KBODY();
        if constexpr (ALIGN_EPI) { if (wr == 0) PG8_BAR; }
        E(acc, cur, wr, wc, fr, fq);
        if (!has_next) break;
#pragma unroll
        for (int a = 0; a < 2; ++a)
#pragma unroll
            for (int b = 0; b < 2; ++b)
#pragma unroll
                for (int m = 0; m < 4; ++m)
#pragma unroll
                    for (int n = 0; n < 2; ++n) acc[a][b][m][n] = (f32x4){0.f, 0.f, 0.f, 0.f};
        cur = nxt; cA0 = nA0; cA1 = nA1; cB = nB; ++ui;
        if constexpr (ASrc::GATHER) {
#pragma unroll
            for (int h = 0; h < 2; ++h) { cvo[h][0] = nvo[h][0]; cvo[h][1] = nvo[h][1]; } }
        if constexpr (ALIGN_EPI) { if (wr == 1) PG8_BAR; }
    }
    PG8_WAIT_V(0);
    if constexpr (!ALIGN_EPI) { if (wr == 0) PG8_BAR; }
    PG8_BAR;
#undef PG8_KBODY
#undef PG8_GOFF
#undef PG8_AVO
#undef PG8_SA
#undef PG8_SB
#undef PG8_STAGE
#undef PG8_LDA
#undef PG8_LDB
#undef PG8_MMA
#undef PG8_WAIT_V
#undef PG8_WAIT_L
#undef PG8_BAR
#undef PG8_SCHED
}
}

constexpr int NWAVES = 8;
constexpr int RING_OFF = 0, RING_BYTES = 131072;
constexpr int LDSCTL_OFF = RING_BYTES, MISC_OFF = LDSCTL_OFF + 320;
constexpr int LDS_BYTES = 147456;
constexpr int NPHASE = 8;
constexpr int CW_CNT = 0;
constexpr int CW_BAR = 4096;

#define XB_TMO      128
#define XB_XCNT(j)  (256  + 64 * (j))
#define XB_XSUB(j)  (1280 + 64 * (j))
#define XB_XGEN(j)  (2304 + 64 * (j))
#define XB_TOP      3328
#define XB_TOPGEN   3392
#define XCD_BAR_WORDS 3456
#define XB_SPIN_CAP (1u << 18)
__device__ __forceinline__ unsigned xb_ld(unsigned* p)              { return __hip_atomic_load(p, __ATOMIC_RELAXED, __HIP_MEMORY_SCOPE_AGENT); }
__device__ __forceinline__ unsigned xb_add(unsigned* p, unsigned v) { return __hip_atomic_fetch_add(p, v, __ATOMIC_RELAXED, __HIP_MEMORY_SCOPE_AGENT); }
__device__ __forceinline__ unsigned xb_xcc_id() { return (unsigned)__builtin_amdgcn_s_getreg((3 << 11) | 20) & 0xFu; }
#define XB_SPIN(cond, bar) do { unsigned _sp = 0; while (cond) { __builtin_amdgcn_s_sleep(1); \
    if ((++_sp & 255u) == 0u) { if (xb_ld(&(bar)[XB_TMO])) break; if (_sp > XB_SPIN_CAP) { atomicAdd(&(bar)[XB_TMO], 1u); break; } } } } while (0)
struct XcdBarrier { unsigned* bar; unsigned x; volatile LAS unsigned* st; };
__device__ __forceinline__ XcdBarrier xcd_barrier_post(unsigned* bar, volatile LAS unsigned* st) {
    XcdBarrier b; b.bar = bar; b.x = xb_xcc_id(); b.st = st;
    if (threadIdx.x == 0) (void)xb_add(&bar[XB_XCNT(b.x)], 1u);
    return b;
}
__device__ __forceinline__ void xcd_barrier_complete(unsigned* bar, unsigned x, unsigned& nloc, unsigned& nx) {
    const unsigned G = gridDim.x * gridDim.y * gridDim.z;
    unsigned sum, cnt, mine, sp = 0u;
    for (;;) {
        sum = 0u; cnt = 0u; mine = 0u;
#pragma unroll
        for (unsigned j = 0; j < 16; ++j) { const unsigned c = xb_ld(&bar[XB_XCNT(j)]); sum += c; cnt += (c > 0u) ? 1u : 0u; mine = (j == x) ? c : mine; }
        if (sum == G) break;
        __builtin_amdgcn_s_sleep(1);
        if ((++sp & 255u) == 0u) { if (xb_ld(&bar[XB_TMO])) break; if (sp > XB_SPIN_CAP) { atomicAdd(&bar[XB_TMO], 1u); break; } }
    }
    nloc = mine > 0u ? mine : 1u; nx = cnt > 0u ? cnt : 1u;
}
__device__ __forceinline__ void xcd_barrier(const XcdBarrier& b) {
    asm volatile("s_waitcnt vmcnt(0)" ::: "memory");
    __syncthreads();
    if (threadIdx.x == 0) {
        unsigned* bar = b.bar;
        __builtin_amdgcn_s_waitcnt(0);
        unsigned nloc = b.st[0], nx = b.st[1];
        if (nloc == 0u) { xcd_barrier_complete(bar, b.x, nloc, nx); b.st[0] = nloc; b.st[1] = nx; }
        const unsigned old = xb_add(&bar[XB_XSUB(b.x)], 1u);
        const unsigned gen = old / nloc;
        if (old + 1u == (gen + 1u) * nloc) {
            __builtin_amdgcn_fence(__ATOMIC_RELEASE, "agent");
            asm volatile("s_waitcnt vmcnt(0)" ::: "memory");
            const unsigned og = xb_add(&bar[XB_TOP], 1u);
            const unsigned tg = og / nx;
            if (og + 1u == (tg + 1u) * nx) xb_add(&bar[XB_TOPGEN], 1u);
            else XB_SPIN(xb_ld(&bar[XB_TOPGEN]) == tg, bar);
            __builtin_amdgcn_fence(__ATOMIC_ACQUIRE, "agent");
            xb_add(&bar[XB_XGEN(b.x)], 1u);
            asm volatile("s_waitcnt vmcnt(0)" ::: "memory");
        } else {
            XB_SPIN(xb_ld(&bar[XB_XGEN(b.x)]) == gen, bar);
            __builtin_amdgcn_fence(__ATOMIC_ACQUIRE, "agent");
            asm volatile("s_waitcnt vmcnt(0)" ::: "memory");
        }
    }
    __syncthreads();
}

struct Args { const float* in[22]; float* out; unsigned char* ws; int ph_lo, ph_hi, li, pad; };


#define LDS_WAIT() asm volatile("s_waitcnt lgkmcnt(0)" ::: "memory")
#define VM_WAIT() asm volatile("s_waitcnt vmcnt(0)" ::: "memory")
__device__ __forceinline__ unsigned pk2(float lo, float hi) { return f2bf(lo) | (f2bf(hi) << 16); }
__device__ __forceinline__ float wave_sum(float v) {
#pragma unroll
    for (int o = 1; o < 64; o <<= 1) v += __shfl_xor(v, o);
    return v;
}
__device__ __forceinline__ void p0_transpose_item(const float* __restrict__ W, int K, int N, bf16_t* __restrict__ WT, const LAS float* gl, const LAS float* bl, float* __restrict__ PS, float* __restrict__ PT,
                                                  int blk, int stride, int off, LAS float* scr, int item, int lane) {
    const int nblk = N / 32, kb = item / nblk, nb = item % nblk, k0 = 64 * kb, n0 = 32 * nb;
    f32x4 v[8];
#pragma unroll
    for (int i = 0; i < 8; ++i) v[i] = *(const f32x4*)(W + (size_t)(k0 + (lane >> 3) + 8 * i) * N + n0 + 4 * (lane & 7));
#pragma unroll
    for (int i = 0; i < 8; ++i) { LAS float* d = scr + ((lane >> 3) + 8 * i) * 33 + 4 * (lane & 7); d[0] = v[i].x; d[1] = v[i].y; d[2] = v[i].z; d[3] = v[i].w; }
    LDS_WAIT();
    const int c = lane & 7;
    float gk[8];
#pragma unroll
    for (int e = 0; e < 8; ++e) gk[e] = gl ? gl[k0 + 8 * c + e] : 1.f;
#pragma unroll
    for (int j = 0; j < 4; ++j) { const int n = (lane >> 3) + 8 * j; const LAS float* sp = scr + (8 * c) * 33 + n;
        u32x4 o; o.x = pk2(sp[0 * 33] * gk[0], sp[1 * 33] * gk[1]); o.y = pk2(sp[2 * 33] * gk[2], sp[3 * 33] * gk[3]); o.z = pk2(sp[4 * 33] * gk[4], sp[5 * 33] * gk[5]); o.w = pk2(sp[6 * 33] * gk[6], sp[7 * 33] * gk[7]);
        const int nn = n0 + n, dr = (nn / blk) * stride + off + nn % blk;
        *(u32x4*)(WT + (size_t)dr * K + k0 + 8 * c) = o; }
    if (PS) {
        const int n = lane & 31, hh = lane >> 5; float sa = 0.f, ta = 0.f;
#pragma unroll 8
        for (int kk = 0; kk < 32; ++kk) { const int k = 32 * hh + kk; const float w = scr[k * 33 + n]; sa += gl[k0 + k] * w; ta += bl[k0 + k] * w; }
        sa += __shfl_xor(sa, 32); ta += __shfl_xor(ta, 32);
        if (lane < 32) { const int nn = n0 + n, dr = (nn / blk) * stride + off + nn % blk; PS[(size_t)kb * NVF + dr] = sa; PT[(size_t)kb * NVF + dr] = ta; }
    }
    LDS_WAIT();
}
__device__ __forceinline__ void p0_prologue(const Args& args, unsigned char* ws, LAS unsigned char* lds, int G) {
    const int tid = threadIdx.x, lane = tid & 63, wave = __builtin_amdgcn_readfirstlane(tid >> 6);
    const float* x = args.in[0]; const float* w_in = args.in[1]; const float* lam = args.in[8]; const float* w_out = args.in[10]; const float* g1 = args.in[11]; const float* b1 = args.in[12];
    const float* rgw = args.in[13]; const float* rgb = args.in[14]; const float* rew = args.in[15];
    const float* wg = args.in[17]; const float* wu = args.in[18]; const float* wd = args.in[19];
    float* vec = (float*)(ws + WS_VEC); float* PS = (float*)(ws + WS_PART); float* PT = PS + (size_t)16 * NVF;
    bf16_t* WIN = (bf16_t*)(ws + WS_WIN); bf16_t* WOUT = (bf16_t*)(ws + WS_WOUT); bf16_t* WR = (bf16_t*)(ws + WS_WR); bf16_t* WGU = (bf16_t*)(ws + WS_WGU); bf16_t* WD = (bf16_t*)(ws + WS_WD);
    bf16_t* XB = (bf16_t*)(ws + WS_XB);
    LAS float* scr = (LAS float*)(lds + wave * 9216);
    LAS float* gl = (LAS float*)(lds + 73728); LAS float* bl = gl + 1024;
    for (int k = tid; k < D; k += NWAVES * 64) { gl[k] = g1[k]; bl[k] = b1[k]; }
    __syncthreads();
    const int gw = (int)blockIdx.x * NWAVES + wave, NGW = G * NWAVES;
    const size_t gtid = (size_t)blockIdx.x * (NWAVES * 64) + tid, NT = (size_t)G * NWAVES * 64;
    constexpr int I_IN = (D / 64) * (NPROJ / 32), I_OUT = (D / 64) * (D / 32), I_RE = (D / 64), I_G = (D / 64) * (DE / 32), I_D = (DE / 64) * (D / 32);
    constexpr int NITEMS = I_IN + I_OUT + I_RE + NE * (2 * I_G + I_D);
    for (int it = gw; it < NITEMS; it += NGW) {
        int r = it;
        if (r < I_IN) { p0_transpose_item(w_in, D, NPROJ, WIN, nullptr, nullptr, nullptr, nullptr, NPROJ, 0, 0, scr, r, lane); continue; } r -= I_IN;
        if (r < I_OUT) { p0_transpose_item(w_out, D, D, WOUT, nullptr, nullptr, nullptr, nullptr, D, 0, 0, scr, r, lane); continue; } r -= I_OUT;
        if (r < I_RE) { p0_transpose_item(rew, D, 32, WR, gl, bl, PS + NE * 512, PT + NE * 512, 32, 0, 4, scr, r, lane); continue; } r -= I_RE;
        if (r < NE * I_G) { const int e = r / I_G; p0_transpose_item(wg + (size_t)e * D * DE, D, DE, WGU + (size_t)e * 512 * D, gl, bl, PS + e * 512, PT + e * 512, 128, 256, 0, scr, r % I_G, lane); continue; } r -= NE * I_G;
        if (r < NE * I_G) { const int e = r / I_G; p0_transpose_item(wu + (size_t)e * D * DE, D, DE, WGU + (size_t)e * 512 * D, gl, bl, PS + e * 512, PT + e * 512, 128, 256, 128, scr, r % I_G, lane); continue; } r -= NE * I_G;
        { const int e = r / I_D; p0_transpose_item(wd + (size_t)e * DE * D, DE, D, WD + (size_t)e * D * DE, nullptr, nullptr, nullptr, nullptr, D, 0, 0, scr, r % I_D, lane); }
    }
    for (size_t i = gtid; i < (size_t)4 * D; i += NT) { const int n = (int)(i / D), k = (int)(i % D); WR[(size_t)n * D + k] = (bf16_t)f2bf(g1[k] * rgw[k * 4 + n]); }
    for (size_t i = gtid; i < (size_t)220 * D / 8; i += NT) ((u32x4*)(WR + 36 * D))[i] = (u32x4){0u, 0u, 0u, 0u};
    if (gw >= 8 && gw < 12) { const int n = gw - 8; float sa = 0.f, ta = 0.f;
        for (int k = lane; k < D; k += 64) { const float w = rgw[k * 4 + n]; sa += g1[k] * w; ta += b1[k] * w; }
        sa = wave_sum(sa); ta = wave_sum(ta);
        if (lane == 0) { vec[V_SR + n] = sa; vec[V_TR + n] = ta + rgb[n]; } }
    if (gtid < DRG) vec[V_SP + gtid] = 8.0f * log1pf(expf(-lam[gtid]));
    for (size_t i = gtid; i < (size_t)T * D / 8; i += NT) { const f32x4 a = ((const f32x4*)x)[2 * i], b = ((const f32x4*)x)[2 * i + 1];
        u32x4 o; o.x = pk2(a.x, a.y); o.y = pk2(a.z, a.w); o.z = pk2(b.x, b.y); o.w = pk2(b.z, b.w); ((u32x4*)XB)[i] = o; }
}
__device__ __forceinline__ void fold_reduce(const Args& args, unsigned char* ws, int G) {
    const float* reb = args.in[16];
    float* vec = (float*)(ws + WS_VEC); const float* PS = (const float*)(ws + WS_PART); const float* PT = PS + (size_t)16 * NVF;
    const size_t gtid = (size_t)blockIdx.x * (NWAVES * 64) + threadIdx.x;
    if (gtid < NVF) { const int idx = (int)gtid; const bool rt = idx >= NE * 512; const int n = idx - NE * 512;
        if (!rt || (n >= 4 && n < 36)) { float sa = 0.f, ta = 0.f;
#pragma unroll
            for (int kb = 0; kb < 16; ++kb) { sa += PS[(size_t)kb * NVF + idx]; ta += PT[(size_t)kb * NVF + idx]; }
            if (!rt) { vec[V_SGU + idx] = sa; vec[V_TGU + idx] = ta; } else { vec[V_SR + n] = sa; vec[V_TR + n] = ta + reb[n - 4]; } } }
}
__device__ __forceinline__ void p2_mixer_simple(const Args& args, unsigned char* ws, LAS unsigned char* lds, int G) {
    const int tid = threadIdx.x, lane = tid & 63, wave = __builtin_amdgcn_readfirstlane(tid >> 6);
    const float* cw = args.in[2]; const float* cb = args.in[3]; const float* Wa = args.in[4]; const float* ba = args.in[5]; const float* Wx = args.in[6]; const float* bx = args.in[7]; const float* scw = args.in[9];
    const float* sp = (const float*)(ws + WS_VEC) + V_SP;
    const bf16_t* PROJ = (const bf16_t*)(ws + WS_PROJ); bf16_t* Y = (bf16_t*)(ws + WS_Y);
    if (wave == 0) {
        LAS float* wa = (LAS float*)lds; LAS float* wx = wa + 4096; LAS float* xs = wx + 4096;
        for (int item = blockIdx.x; item < NBATCH * 8; item += G) {
            const int b = item >> 3, h = item & 7, c = h * 64 + lane;
            for (int i = 0; i < 64; ++i) { wa[i * 64 + lane] = Wa[(h * 64 + i) * 64 + lane]; wx[i * 64 + lane] = Wx[(h * 64 + i) * 64 + lane]; }
            const float w0 = cw[0 * DRG + c], w1 = cw[1 * DRG + c], w2 = cw[2 * DRG + c], w3 = cw[3 * DRG + c], cbias = cb[c], bac = ba[c], bxc = bx[c], spc = sp[c];
            float x0 = 0.f, x1 = 0.f, x2 = 0.f, hs = 0.f;
            LDS_WAIT();
            for (int t = 0; t < SEQ; ++t) {
                const size_t row = (size_t)b * SEQ + t;
                const float x3 = bf2f(PROJ[row * NPROJ + c]);
                const float xc = cbias + w0 * x0 + w1 * x1 + w2 * x2 + w3 * x3;
                x0 = x1; x1 = x2; x2 = x3;
                xs[lane] = xc;
                LDS_WAIT();
                float ra = bac, rx = bxc;
#pragma unroll 8
                for (int i = 0; i < 64; ++i) { const float v = xs[i]; ra += v * wa[i * 64 + lane]; rx += v * wx[i * 64 + lane]; }
                const float r = sigmoidf_(ra), ii = sigmoidf_(rx);
                const float la = -spc * r, a = __expf(la), mult = sqrtf(fmaxf(1.f - a * a, 0.f));
                hs = a * hs + mult * (ii * xc);
                const float gate = bf2f(PROJ[row * NPROJ + DRG + c]);
                Y[row * D + c] = (bf16_t)f2bf(hs * gelu_tanh(gate));
                LDS_WAIT();
            }
        }
    }
    const size_t gtid = (size_t)blockIdx.x * (NWAVES * 64) + tid, NT = (size_t)G * NWAVES * 64;
    for (size_t i = gtid; i < (size_t)T * DRG; i += NT) {
        const int c = (int)(i % DRG); const size_t row = i / DRG; const int t = (int)(row % SEQ);
        float s = 0.f;
#pragma unroll
        for (int k = 0; k < 3; ++k) { const int tt = t - 2 + k; if (tt >= 0) { const size_t r2 = row - 2 + k; s += scw[k * DRG + c] * (bf2f(PROJ[r2 * NPROJ + 1536 + c]) * bf2f(PROJ[r2 * NPROJ + 2048 + c])); } }
        Y[row * D + DRG + c] = (bf16_t)f2bf(bf2f(PROJ[row * NPROJ + 1024 + c]) * s);
    }
}

namespace mix {
constexpr int L = 128, NCH = SEQ / L;
constexpr int XT_OFF = 0, GT_OFF = 16896, AT_OFF = GT_OFF + 8192, A_OFF = AT_OFF + 16384, U_OFF = A_OFF + 16384, YT_OFF = U_OFF + 16384, SEG_OFF = YT_OFF + 8192, HC_OFF = SEG_OFF + 4096;
__device__ __forceinline__ float sigm(float x) { return __builtin_amdgcn_rcpf(1.f + __expf(-x)); }
__device__ __forceinline__ float gelu_t(float x) { const float u = 1.5957691216057308f * (x + 0.044715f * x * x * x); return x * __builtin_amdgcn_rcpf(1.f + __expf(-u)); }
}
__device__ __forceinline__ void p2_mixer(const Args& args, unsigned char* ws, LAS unsigned char* lds, int G) {
    using namespace mix;
    const int tid = threadIdx.x, lane = tid & 63, wave = __builtin_amdgcn_readfirstlane(tid >> 6), fr = lane & 15, fq = lane >> 4;
    const float* cw = args.in[2]; const float* cb = args.in[3]; const float* Wa = args.in[4]; const float* ba = args.in[5]; const float* Wx = args.in[6]; const float* bx = args.in[7]; const float* scw = args.in[9];
    const float* sp = (const float*)(ws + WS_VEC) + V_SP;
    const bf16_t* PROJ = (const bf16_t*)(ws + WS_PROJ); bf16_t* Y = (bf16_t*)(ws + WS_Y);
    LAS unsigned char* XT = lds + XT_OFF; LAS unsigned char* GT = lds + GT_OFF; LAS unsigned char* AT = lds + AT_OFF; LAS float* At_ = (LAS float*)(lds + A_OFF); LAS float* Ut_ = (LAS float*)(lds + U_OFF);
    LAS unsigned char* YT = lds + YT_OFF; LAS f32x2* SEG = (LAS f32x2*)(lds + SEG_OFF); LAS float* HC = (LAS float*)(lds + HC_OFF);
    for (int item = blockIdx.x; item < NBATCH * 16; item += G) {
        const int b = item >> 4, h = (item >> 1) & 7, half = item & 1;
        const size_t rowb = (size_t)b * SEQ;
        const int c8 = tid & 7;
        float cwt[4][8], cbi[8];
#pragma unroll
        for (int k = 0; k < 4; ++k) { const f32x4 a = *(const f32x4*)(cw + k * DRG + h * 64 + 8 * c8), bq = *(const f32x4*)(cw + k * DRG + h * 64 + 8 * c8 + 4);
            cwt[k][0] = a.x; cwt[k][1] = a.y; cwt[k][2] = a.z; cwt[k][3] = a.w; cwt[k][4] = bq.x; cwt[k][5] = bq.y; cwt[k][6] = bq.z; cwt[k][7] = bq.w; }
        { const f32x4 a = *(const f32x4*)(cb + h * 64 + 8 * c8), bq = *(const f32x4*)(cb + h * 64 + 8 * c8 + 4); cbi[0] = a.x; cbi[1] = a.y; cbi[2] = a.z; cbi[3] = a.w; cbi[4] = bq.x; cbi[5] = bq.y; cbi[6] = bq.z; cbi[7] = bq.w; }
        bf16x8 Bf[2][2][2];
#pragma unroll
        for (int gt = 0; gt < 2; ++gt)
#pragma unroll
            for (int nb = 0; nb < 2; ++nb)
#pragma unroll
                for (int ks = 0; ks < 2; ++ks) { const float* Wp = (gt ? Wx : Wa) + ((size_t)h * 64 + 32 * ks + 8 * fq) * 64 + half * 32 + 16 * nb + fr; bf16x8 v;
#pragma unroll
                    for (int e = 0; e < 8; ++e) v[e] = (short)f2bf(Wp[e * 64]);
                    Bf[gt][nb][ks] = v; }
        float bae[2], bxe[2], spe[2];
#pragma unroll
        for (int nb = 0; nb < 2; ++nb) { const int j = h * 64 + half * 32 + 16 * nb + fr; bae[nb] = ba[j]; bxe[nb] = bx[j]; spe[nb] = sp[j]; }
        if (tid < 64) HC[tid] = 0.f;
        u32x4 px[3], pg;
#define MIX_LOAD(ch) do { const int t0_ = (ch) * L; \
            _Pragma("unroll") for (int i = 0; i < 3; ++i) { const int p = tid + 512 * i; const int r = p >> 3, tt = t0_ - 3 + r; px[i] = (u32x4){0u, 0u, 0u, 0u}; \
                if (p < 131 * 8 && tt >= 0) px[i] = *(const u32x4*)(PROJ + (rowb + tt) * NPROJ + h * 64 + 8 * (p & 7)); } \
            pg = *(const u32x4*)(PROJ + (rowb + t0_ + (tid >> 2)) * NPROJ + DRG + h * 64 + half * 32 + 8 * (tid & 3)); } while (0)
        MIX_LOAD(0);
        for (int ch = 0; ch < NCH; ++ch) {
            const int t0 = ch * L;
#pragma unroll
            for (int i = 0; i < 3; ++i) { const int p = tid + 512 * i; if (p < 131 * 8) *(LAS u32x4*)(XT + p * 16) = px[i]; }
            *(LAS u32x4*)(GT + tid * 16) = pg;
            __syncthreads();
            if (ch + 1 < NCH) MIX_LOAD(ch + 1);
#pragma unroll
            for (int k2 = 0; k2 < 2; ++k2) { const int t = (tid >> 3) + 64 * k2; float acc8[8];
#pragma unroll
                for (int e = 0; e < 8; ++e) acc8[e] = cbi[e];
#pragma unroll
                for (int k = 0; k < 4; ++k) { const u32x4 v = *(const LAS u32x4*)(XT + (t + k) * 128 + c8 * 16); const unsigned w4[4] = {v.x, v.y, v.z, v.w};
#pragma unroll
                    for (int e = 0; e < 4; ++e) { acc8[2 * e] += cwt[k][2 * e] * bf2f(w4[e]); acc8[2 * e + 1] += cwt[k][2 * e + 1] * bf2f(w4[e] >> 16); } }
                u32x4 o; o.x = pk2(acc8[0], acc8[1]); o.y = pk2(acc8[2], acc8[3]); o.z = pk2(acc8[4], acc8[5]); o.w = pk2(acc8[6], acc8[7]);
                *(LAS u32x4*)(AT + t * 128 + ((c8 ^ (t & 7)) << 4)) = o; }
            __syncthreads();
            f32x4 accg[2][2];
            { const int t = 16 * wave + fr; bf16x8 Af[2];
#pragma unroll
                for (int ks = 0; ks < 2; ++ks) Af[ks] = *(const LAS bf16x8*)(AT + t * 128 + (((ks * 4 + fq) ^ (t & 7)) << 4));
#pragma unroll
                for (int gt = 0; gt < 2; ++gt)
#pragma unroll
                    for (int nb = 0; nb < 2; ++nb) { f32x4 c = {0.f, 0.f, 0.f, 0.f};
#pragma unroll
                        for (int ks = 0; ks < 2; ++ks) c = __builtin_amdgcn_mfma_f32_16x16x32_bf16(Af[ks], Bf[gt][nb][ks], c, 0, 0, 0);
                        accg[gt][nb] = c; } }
#pragma unroll
            for (int nb = 0; nb < 2; ++nb)
#pragma unroll
                for (int rg = 0; rg < 4; ++rg) { const int t = 16 * wave + 4 * fq + rg, jj = 16 * nb + fr, ci = half * 32 + jj;
                    const float xc = bf2f(*(const LAS unsigned short*)(AT + t * 128 + (((ci >> 3) ^ (t & 7)) << 4) + (ci & 7) * 2));
                    const float r = sigm(accg[0][nb][rg] + bae[nb]), ig = sigm(accg[1][nb][rg] + bxe[nb]);
                    const float a = __expf(-spe[nb] * r), mult = __builtin_amdgcn_sqrtf(fmaxf(1.f - a * a, 0.f));
                    At_[t * 32 + jj] = a; Ut_[t * 32 + jj] = mult * ig * xc; }
            __syncthreads();
            { const int jj = tid & 31, seg = tid >> 5; float av[8], uv[8]; float Aq = 1.f, Hq = 0.f;
#pragma unroll
                for (int s2 = 0; s2 < 8; ++s2) { av[s2] = At_[(8 * seg + s2) * 32 + jj]; uv[s2] = Ut_[(8 * seg + s2) * 32 + jj]; Hq = av[s2] * Hq + uv[s2]; Aq *= av[s2]; }
                SEG[seg * 32 + jj] = (f32x2){Aq, Hq};
                __syncthreads();
                float hh = HC[(ch & 1) * 32 + jj];
                for (int q = 0; q < seg; ++q) { const f32x2 sg = SEG[q * 32 + jj]; hh = sg.x * hh + sg.y; }
                if (seg == 15) HC[((ch + 1) & 1) * 32 + jj] = Aq * hh + Hq;
#pragma unroll
                for (int s2 = 0; s2 < 8; ++s2) { const int t = 8 * seg + s2; hh = av[s2] * hh + uv[s2];
                    const float gv = bf2f(*(const LAS unsigned short*)(GT + t * 64 + jj * 2));
                    *(LAS unsigned short*)(YT + t * 64 + jj * 2) = (unsigned short)f2bf(hh * gelu_t(gv)); } }
            __syncthreads();
            *(u32x4*)(Y + (rowb + t0 + (tid >> 2)) * D + h * 64 + half * 32 + 8 * (tid & 3)) = *(const LAS u32x4*)(YT + tid * 16);
        }
#undef MIX_LOAD
        __syncthreads();
    }
    {
        const int c0 = 8 * lane;
        float w3[3][8];
#pragma unroll
        for (int k = 0; k < 3; ++k) { const f32x4 a = *(const f32x4*)(scw + k * DRG + c0), bq = *(const f32x4*)(scw + k * DRG + c0 + 4);
            w3[k][0] = a.x; w3[k][1] = a.y; w3[k][2] = a.z; w3[k][3] = a.w; w3[k][4] = bq.x; w3[k][5] = bq.y; w3[k][6] = bq.z; w3[k][7] = bq.w; }
        for (int it = (int)blockIdx.x * NWAVES + wave; it < T / 16; it += G * NWAVES) {
            const size_t r0 = (size_t)it * 16; const int tq = (int)(r0 % SEQ);
            float cv1[8], cv2[8];
#pragma unroll
            for (int e = 0; e < 8; ++e) { cv1[e] = 0.f; cv2[e] = 0.f; }
            if (tq > 0) {
#pragma unroll
                for (int hh = 0; hh < 2; ++hh) { const size_t r = r0 - 2 + hh; const u32x4 cc = *(const u32x4*)(PROJ + r * NPROJ + 1536 + c0), vv = *(const u32x4*)(PROJ + r * NPROJ + 2048 + c0);
                    const unsigned cw4[4] = {cc.x, cc.y, cc.z, cc.w}, vw4[4] = {vv.x, vv.y, vv.z, vv.w};
#pragma unroll
                    for (int e = 0; e < 4; ++e) { const float p0 = bf2f(cw4[e]) * bf2f(vw4[e]), p1 = bf2f(cw4[e] >> 16) * bf2f(vw4[e] >> 16);
                        if (hh == 0) { cv2[2 * e] = p0; cv2[2 * e + 1] = p1; } else { cv1[2 * e] = p0; cv1[2 * e + 1] = p1; } } } }
#pragma unroll 4
            for (int s2 = 0; s2 < 16; ++s2) { const size_t r = r0 + s2;
                const u32x4 bb = *(const u32x4*)(PROJ + r * NPROJ + 1024 + c0), cc = *(const u32x4*)(PROJ + r * NPROJ + 1536 + c0), vv = *(const u32x4*)(PROJ + r * NPROJ + 2048 + c0);
                const unsigned bw4[4] = {bb.x, bb.y, bb.z, bb.w}, cw4[4] = {cc.x, cc.y, cc.z, cc.w}, vw4[4] = {vv.x, vv.y, vv.z, vv.w};
                float yv[8];
#pragma unroll
                for (int e = 0; e < 4; ++e) { const float p0 = bf2f(cw4[e]) * bf2f(vw4[e]), p1 = bf2f(cw4[e] >> 16) * bf2f(vw4[e] >> 16);
                    yv[2 * e] = bf2f(bw4[e]) * (w3[0][2 * e] * cv2[2 * e] + w3[1][2 * e] * cv1[2 * e] + w3[2][2 * e] * p0);
                    yv[2 * e + 1] = bf2f(bw4[e] >> 16) * (w3[0][2 * e + 1] * cv2[2 * e + 1] + w3[1][2 * e + 1] * cv1[2 * e + 1] + w3[2][2 * e + 1] * p1);
                    cv2[2 * e] = cv1[2 * e]; cv2[2 * e + 1] = cv1[2 * e + 1]; cv1[2 * e] = p0; cv1[2 * e + 1] = p1; }
                u32x4 o; o.x = pk2(yv[0], yv[1]); o.y = pk2(yv[2], yv[3]); o.z = pk2(yv[4], yv[5]); o.w = pk2(yv[6], yv[7]);
                *(u32x4*)(Y + r * D + DRG + c0) = o; }
        }
    }
}
__device__ __forceinline__ void p4_route_tile(int pm, const float* __restrict__ LG, const float2* __restrict__ PS, const float* __restrict__ SR, const float* __restrict__ TR,
                                              unsigned* cnt, float4* __restrict__ SLOT, int* __restrict__ TOKSLOT, volatile LAS unsigned* MISC) {
    const int tid = threadIdx.x;
    LAS unsigned* hist = (LAS unsigned*)(MISC + 96); LAS unsigned* gbase = (LAS unsigned*)(MISC + 128);
    if (tid < 32) hist[tid] = 0u;
    __syncthreads();
    int ea = 0, eb = 0; unsigned ra = 0, rb = 0; float w1 = 0.f, w2 = 0.f, mu = 0.f, rstd = 0.f; const int t = pm * 256 + tid;
    if (tid < 256) {
        float s = 0.f, q = 0.f;
#pragma unroll
        for (int j = 0; j < 8; ++j) { const f32x4 a = *(const f32x4*)((const float*)(PS + (size_t)t * 16) + 4 * j); s += a.x + a.z; q += a.y + a.w; }
        mu = s * (1.f / D); rstd = 1.f / sqrtf(fmaxf(q * (1.f / D) - mu * mu, 0.f) + LN_EPS);
        float lg[36];
#pragma unroll
        for (int j = 0; j < 9; ++j) { const f32x4 a = *(const f32x4*)(LG + (size_t)t * 64 + 4 * j); lg[4 * j] = a.x; lg[4 * j + 1] = a.y; lg[4 * j + 2] = a.z; lg[4 * j + 3] = a.w; }
#pragma unroll
        for (int j = 0; j < 36; ++j) lg[j] = rstd * (lg[j] - mu * SR[j]) + TR[j];
        int g = 0; float gm = lg[0];
#pragma unroll
        for (int j = 1; j < NGRP; ++j) if (lg[j] > gm) { gm = lg[j]; g = j; }
        float den = 0.f;
#pragma unroll
        for (int j = 0; j < NGRP; ++j) den += __expf(lg[j] - gm);
        const float gp = 1.f / den;
        float el[EPG];
#pragma unroll
        for (int j = 0; j < EPG; ++j) el[j] = g == 0 ? lg[4 + j] : g == 1 ? lg[12 + j] : g == 2 ? lg[20 + j] : lg[28 + j];
        int i1 = 0; float v1 = el[0];
#pragma unroll
        for (int j = 1; j < EPG; ++j) if (el[j] > v1) { v1 = el[j]; i1 = j; }
        int i2 = 0; float v2 = -INFINITY;
#pragma unroll
        for (int j = 0; j < EPG; ++j) if (j != i1 && el[j] > v2) { v2 = el[j]; i2 = j; }
        const float e2 = __expf(v2 - v1); w1 = gp / (1.f + e2); w2 = gp * e2 / (1.f + e2);
        ea = g * EPG + i1; eb = g * EPG + i2;
        ra = __hip_atomic_fetch_add(&hist[ea], 1u, __ATOMIC_RELAXED, __HIP_MEMORY_SCOPE_WORKGROUP); rb = __hip_atomic_fetch_add(&hist[eb], 1u, __ATOMIC_RELAXED, __HIP_MEMORY_SCOPE_WORKGROUP);
    }
    __syncthreads();
    if (tid < 32) gbase[tid] = hist[tid] ? __hip_atomic_fetch_add(cnt + tid, hist[tid], __ATOMIC_RELAXED, __HIP_MEMORY_SCOPE_AGENT) : 0u;
    __syncthreads();
    if (tid < 256) {
        const int pa = (int)(gbase[ea] + ra), pb = (int)(gbase[eb] + rb);
        SLOT[(size_t)ea * T + pa] = make_float4(__builtin_bit_cast(float, t), rstd, mu, w1);
        SLOT[(size_t)eb * T + pb] = make_float4(__builtin_bit_cast(float, t), rstd, mu, w2);
        TOKSLOT[t * 2 + 0] = ea * T + pa; TOKSLOT[t * 2 + 1] = eb * T + pb;
    }
    __syncthreads();
}
__device__ __forceinline__ void p7_final(const Args& args, unsigned char* ws, const LAS int* pref, int G) {
    const int tid = threadIdx.x, lane = tid & 63, wave = __builtin_amdgcn_readfirstlane(tid >> 6);
    const float* g1 = args.in[11]; const float* b1 = args.in[12]; const float* g2 = args.in[20]; const float* b2 = args.in[21];
    const bf16_t* Z = (const bf16_t*)(ws + WS_Z); const bf16_t* C = (const bf16_t*)(ws + WS_PROJ); const float2* PS = (const float2*)(ws + WS_PSTATS); const int* TOKSLOT = (const int*)(ws + WS_TOKSLOT);
    float* out = args.out;
    f32x4 G1[4], B1[4], G2[4], B2[4];
#pragma unroll
    for (int j = 0; j < 4; ++j) { const int c = 4 * lane + 256 * j; G1[j] = *(const f32x4*)(g1 + c); B1[j] = *(const f32x4*)(b1 + c); G2[j] = *(const f32x4*)(g2 + c); B2[j] = *(const f32x4*)(b2 + c); }
    for (int t = (int)blockIdx.x * NWAVES + wave; t < T; t += G * NWAVES) {
        const float2 ps = PS[(size_t)t * 16 + (lane & 15)];
        float s = ps.x, q = ps.y;
#pragma unroll
        for (int o = 1; o < 16; o <<= 1) { s += __shfl_xor(s, o); q += __shfl_xor(q, o); }
        const float mu = s * (1.f / D), rstd = 1.f / sqrtf(fmaxf(q * (1.f / D) - mu * mu, 0.f) + LN_EPS);
        const int s1 = TOKSLOT[t * 2], s2 = TOKSLOT[t * 2 + 1];
        const size_t r1 = (size_t)pref[s1 >> 15] * 256 + (s1 & (T - 1)), r2 = (size_t)pref[s2 >> 15] * 256 + (s2 & (T - 1));
        f32x4 v[4]; float sum = 0.f;
#pragma unroll
        for (int j = 0; j < 4; ++j) { const int c = 4 * lane + 256 * j;
            const uint2 zz = *(const uint2*)(Z + (size_t)t * D + c), c1 = *(const uint2*)(C + r1 * D + c), c2 = *(const uint2*)(C + r2 * D + c);
            f32x4 zf = {bf2f(zz.x), bf2f(zz.x >> 16), bf2f(zz.y), bf2f(zz.y >> 16)};
            f32x4 cf = {bf2f(c1.x) + bf2f(c2.x), bf2f(c1.x >> 16) + bf2f(c2.x >> 16), bf2f(c1.y) + bf2f(c2.y), bf2f(c1.y >> 16) + bf2f(c2.y >> 16)};
            v[j] = ALPHA * ((zf - mu) * rstd * G1[j] + B1[j]) + cf; sum += (v[j].x + v[j].y) + (v[j].z + v[j].w); }
        const float m2 = wave_sum(sum) * (1.f / D); float qq = 0.f;
#pragma unroll
        for (int j = 0; j < 4; ++j) { v[j] = v[j] - m2; qq += (v[j].x * v[j].x + v[j].y * v[j].y) + (v[j].z * v[j].z + v[j].w * v[j].w); }
        const float r2s = 1.f / sqrtf(wave_sum(qq) * (1.f / D) + LN_EPS);
#pragma unroll
        for (int j = 0; j < 4; ++j) *(f32x4*)(out + (size_t)t * D + 4 * lane + 256 * j) = v[j] * r2s * G2[j] + B2[j];
    }
}

__global__ void __launch_bounds__(NWAVES * 64, 2) mk_fwd(Args args) {
    extern __shared__ __attribute__((aligned(16))) unsigned char lds_raw[];
    LAS unsigned char* lds = (LAS unsigned char*)lds_raw;
    volatile LAS unsigned* MISC = (volatile LAS unsigned*)(lds + MISC_OFF);
    const int tid = threadIdx.x;
    const int G = gridDim.x;
    unsigned char* ws = args.ws;
    unsigned* ctl = (unsigned*)(ws + WS_CTL);
    float* vec = (float*)(ws + WS_VEC);
    bf16_t* WIN = (bf16_t*)(ws + WS_WIN); bf16_t* WOUT = (bf16_t*)(ws + WS_WOUT); bf16_t* WGU = (bf16_t*)(ws + WS_WGU); bf16_t* WD = (bf16_t*)(ws + WS_WD);
    bf16_t* XB = (bf16_t*)(ws + WS_XB); bf16_t* PROJ = (bf16_t*)(ws + WS_PROJ); bf16_t* CONTRIB = (bf16_t*)(ws + WS_PROJ);
    bf16_t* Y = (bf16_t*)(ws + WS_Y); bf16_t* Z = (bf16_t*)(ws + WS_Z); bf16_t* HID = (bf16_t*)(ws + WS_HID);
    float4* SLOT = (float4*)(ws + WS_SLOT); float2* PS = (float2*)(ws + WS_PSTATS);
    for (int u = tid; u < (LDS_BYTES - LDSCTL_OFF) / 4; u += NWAVES * 64) ((LAS unsigned*)(lds + LDSCTL_OFF))[u] = 0u;
    __syncthreads();
    XcdBarrier bar = xcd_barrier_post(ctl + CW_BAR + args.li * XCD_BAR_WORDS, MISC + 8);
    const int lo = args.ph_lo, hi = args.ph_hi;
#ifndef REP_PH
#define REP_PH -1
#endif
#define NREP(k) ((k) == REP_PH ? 2 : 1)
#define IN(k) (lo <= (k) && (k) < hi)
#define BOTH(k) (IN(k) && IN((k) + 1))
#define GRID_BAR() xcd_barrier(bar)

    if (IN(0)) { for (int rep = 0; rep < NREP(0); ++rep) p0_prologue(args, ws, lds, G); if (BOTH(0)) GRID_BAR(); }
    if (IN(1)) {
        pg8::StaticOrder S; S.init(T, NPROJ, G, (int)blockIdx.x);
        pg8::EpiBf16 E{PROJ, NPROJ, 0xffff};
        pg8::gemm_phase<pg8::EpiBf16, pg8::StaticOrder, pg8::DenseA, true>(lds + RING_OFF, XB, WIN, D, S, E, pg8::DenseA{});
        if (NREP(1) == 2) pg8::gemm_phase<pg8::EpiBf16, pg8::StaticOrder, pg8::DenseA, true>(lds + RING_OFF, XB, WIN, D, S, E, pg8::DenseA{});
        if (BOTH(1)) GRID_BAR();
    }
#if MK_MIX_SIMPLE
    if (IN(2)) { fold_reduce(args, ws, G); p2_mixer_simple(args, ws, lds, G); if (BOTH(2)) GRID_BAR(); }
#else
    if (IN(2)) { fold_reduce(args, ws, G); for (int rep = 0; rep < NREP(2); ++rep) p2_mixer(args, ws, lds, G); if (BOTH(2)) GRID_BAR(); }
#endif
    if (IN(3)) {
        pg8::StaticOrder S; S.init(T, D, G, (int)blockIdx.x);
        pg8::EpiZ E{XB, Z, PS};
        pg8::gemm_phase<pg8::EpiZ, pg8::StaticOrder, pg8::DenseA, true>(lds + RING_OFF, Y, WOUT, D, S, E, pg8::DenseA{});
        if (NREP(3) == 2) pg8::gemm_phase<pg8::EpiZ, pg8::StaticOrder, pg8::DenseA, true>(lds + RING_OFF, Y, WOUT, D, S, E, pg8::DenseA{});
        if (BOTH(3)) GRID_BAR();
    }
    if (IN(4)) {
        float* LG = (float*)(ws + WS_HID);
        pg8::StaticOrder S; S.init(T, 256, G, (int)blockIdx.x);
        pg8::EpiLogits E{LG};
        pg8::gemm_phase<pg8::EpiLogits, pg8::StaticOrder, pg8::DenseA, true>(lds + RING_OFF, Z, (const bf16_t*)(ws + WS_WR), D, S, E, pg8::DenseA{});
        pg8::Unit u;
        if (S.next(0, u)) {
            VM_WAIT(); __syncthreads();
            __builtin_amdgcn_fence(__ATOMIC_ACQUIRE, "agent"); VM_WAIT();
            p4_route_tile(u.pm, LG, PS, vec + V_SR, vec + V_TR, ctl + CW_CNT, SLOT, (int*)(ws + WS_TOKSLOT), MISC);
        }
        if (BOTH(4)) GRID_BAR();
    }
    if (IN(5) || IN(6) || IN(7)) {
        if (tid < 32) MISC[64 + tid] = ctl[CW_CNT + tid];
        __syncthreads();
        if (tid == 0) { int s = 0; for (int e = 0; e < NE; ++e) { MISC[16 + e] = (unsigned)s; s += ((int)MISC[64 + e] + 255) / 256; } MISC[16 + NE] = (unsigned)s; }
        __syncthreads();
        const LAS int* pref = (const LAS int*)(lds + MISC_OFF) + 16; const LAS int* cntl = (const LAS int*)(lds + MISC_OFF) + 64;
        const int ntiles = pref[NE];
        if (IN(5)) {
            pg8::MoeOrder S{pref, 2, ntiles * 2, G, (int)blockIdx.x};
            LAS int* toks = (LAS int*)(lds + MISC_OFF + 1024);
            { pg8::Unit u; for (int i = 0; i < 4 && S.next(i, u); ++i) { if (tid < 256) { const int pos = u.tl * 256 + tid; toks[i * 256 + tid] = pos < cntl[u.e] ? __builtin_bit_cast(int, SLOT[(size_t)u.e * T + pos].x) : 0; } } }
            __syncthreads();
            pg8::EpiGU E{SLOT, vec + V_SGU, vec + V_TGU, HID};
            pg8::GatherA AS{toks};
            for (int rep = 0; rep < NREP(5); ++rep) pg8::gemm_phase<pg8::EpiGU, pg8::MoeOrder, pg8::GatherA, true>(lds + RING_OFF, Z, WGU, D, S, E, AS);
            if (BOTH(5)) GRID_BAR();
        }
        if (IN(6)) {
            pg8::MoeOrder S{pref, 4, ntiles * 4, G, (int)blockIdx.x};
            pg8::EpiBf16 E{CONTRIB, D, 3};
            for (int rep = 0; rep < NREP(6); ++rep) pg8::gemm_phase<pg8::EpiBf16, pg8::MoeOrder, pg8::DenseA, true>(lds + RING_OFF, HID, WD, DE, S, E, pg8::DenseA{});
            if (BOTH(6)) GRID_BAR();
        }
        if (IN(7)) for (int rep = 0; rep < NREP(7); ++rep) p7_final(args, ws, pref, G);
    }
#undef IN
#undef BOTH
#undef GRID_BAR
}

static int mk_grid() {
    static int grid = 0;
    if (grid == 0) {
        int dev = 0, cus = 0;
        if (hipGetDevice(&dev) != hipSuccess || hipDeviceGetAttribute(&cus, hipDeviceAttributeMultiprocessorCount, dev) != hipSuccess) { grid = -1; return grid; }
        if (hipFuncSetAttribute((const void*)mk_fwd, hipFuncAttributeMaxDynamicSharedMemorySize, LDS_BYTES) != hipSuccess) { grid = -1; return grid; }
        int per_cu = 0;
        if (hipOccupancyMaxActiveBlocksPerMultiprocessor(&per_cu, (const void*)mk_fwd, NWAVES * 64, LDS_BYTES) != hipSuccess || per_cu < 1) { (void)hipGetLastError(); grid = -1; return grid; }
        grid = cus;
    }
    return grid;
}
static int g_li = 0;
static void mk_launch(const Args& base, int lo, int hi, hipStream_t stream) {
    const int grid = mk_grid(); if (grid <= 0) return;
    Args a = base; a.ph_lo = lo; a.ph_hi = hi; a.li = g_li++;
    hipLaunchKernelGGL(mk_fwd, dim3(grid), dim3(NWAVES * 64), LDS_BYTES, stream, a);
}

extern "C" void kernel_launch(void* const* d_in, const int* in_sizes, int n_in, void* d_out, int out_size, void* d_ws, size_t ws_size, hipStream_t stream) {
    if (ws_size < WS_END || n_in != 22) return;
    const float* x = (const float*)d_in[0]; const float* w_in = (const float*)d_in[1]; const float* rg_cw = (const float*)d_in[2]; const float* rg_cb = (const float*)d_in[3];
    const float* Wa = (const float*)d_in[4]; const float* ba = (const float*)d_in[5]; const float* Wx = (const float*)d_in[6]; const float* bx = (const float*)d_in[7];
    const float* lam = (const float*)d_in[8]; const float* sc_cw = (const float*)d_in[9]; const float* w_out = (const float*)d_in[10]; const float* g1 = (const float*)d_in[11]; const float* b1 = (const float*)d_in[12];
    const float* rgw = (const float*)d_in[13]; const float* rgb = (const float*)d_in[14]; const float* rew = (const float*)d_in[15]; const float* reb = (const float*)d_in[16];
    const float* wg = (const float*)d_in[17]; const float* wu = (const float*)d_in[18]; const float* wd = (const float*)d_in[19]; const float* g2 = (const float*)d_in[20]; const float* b2 = (const float*)d_in[21];
    char* ws = (char*)d_ws;
    int* cnt = (int*)(ws + WS_CTL); float* vec = (float*)(ws + WS_VEC); int* base = (int*)(vec + V_BASE);
    bf16_t* WIN = (bf16_t*)(ws + WS_WIN); bf16_t* WOUT = (bf16_t*)(ws + WS_WOUT); bf16_t* WR = (bf16_t*)(ws + WS_WR); bf16_t* WGU = (bf16_t*)(ws + WS_WGU); bf16_t* WD = (bf16_t*)(ws + WS_WD);
    bf16_t* XB = (bf16_t*)(ws + WS_XB); bf16_t* PROJ = (bf16_t*)(ws + WS_PROJ); float* GU = (float*)(ws + WS_PROJ); bf16_t* CONTRIB = (bf16_t*)(ws + WS_PROJ);
    bf16_t* Y = (bf16_t*)(ws + WS_Y); bf16_t* Z = (bf16_t*)(ws + WS_Z); bf16_t* HID = (bf16_t*)(ws + WS_HID);
    float4* SLOT = (float4*)(ws + WS_SLOT); int* TOKSLOT = (int*)(ws + WS_TOKSLOT); float2* PS = (float2*)(ws + WS_PSTATS);
    (void)GU; (void)PROJ; (void)CONTRIB; (void)HID; (void)XB; (void)WGU; (void)WD; (void)WIN; (void)WOUT;
    Args a{}; for (int i = 0; i < 22; ++i) a.in[i] = (const float*)d_in[i]; a.out = (float*)d_out; a.ws = (unsigned char*)d_ws;
    g_li = 0;

    (void)hipMemsetAsync(ws + WS_CTL, 0, CTL_BYTES, stream);
#if MK_ALL
    mk_launch(a, 0, 8, stream);
    return;
#endif
#if MK_P0
    mk_launch(a, 0, 1, stream);
#else
    k_cvt_x<<<2048, 256, 0, stream>>>(x, XB, (size_t)T * D / 4);
    k_tconv<<<dim3(NPROJ / 32, D / 32, 1), dim3(32, 8), 0, stream>>>(w_in, D, NPROJ, 0, WIN, 0, nullptr, NPROJ, 0, 0);
    k_tconv<<<dim3(D / 32, D / 32, 1), dim3(32, 8), 0, stream>>>(w_out, D, D, 0, WOUT, 0, nullptr, D, 0, 0);
    k_zero16<<<256, 256, 0, stream>>>(WR, (size_t)256 * D);
    k_tconv<<<dim3(1, D / 32, 1), dim3(32, 8), 0, stream>>>(rew, D, 32, 0, WR, 0, g1, 32, 0, 4);
    k_foldvec<<<dim3(1, 1), 64, 0, stream>>>(rew, D, 32, 0, g1, b1, reb, vec + V_SR, vec + V_TR, 0, 32, 0, 4);
    k_foldvec<<<dim3(1, 1), 64, 0, stream>>>(rgw, D, 4, 0, g1, b1, rgb, vec + V_SR, vec + V_TR, 0, 4, 0, 0);
    k_tconv<<<dim3(DE / 32, D / 32, NE), dim3(32, 8), 0, stream>>>(wg, D, DE, (size_t)D * DE, WGU, (size_t)512 * D, g1, 128, 256, 0);
    k_tconv<<<dim3(DE / 32, D / 32, NE), dim3(32, 8), 0, stream>>>(wu, D, DE, (size_t)D * DE, WGU, (size_t)512 * D, g1, 128, 256, 128);
    k_foldvec<<<dim3(1, NE), 256, 0, stream>>>(wg, D, DE, (size_t)D * DE, g1, b1, nullptr, vec + V_SGU, vec + V_TGU, 512, 128, 256, 0);
    k_foldvec<<<dim3(1, NE), 256, 0, stream>>>(wu, D, DE, (size_t)D * DE, g1, b1, nullptr, vec + V_SGU, vec + V_TGU, 512, 128, 256, 128);
    k_tconv<<<dim3(D / 32, DE / 32, NE), dim3(32, 8), 0, stream>>>(wd, DE, D, (size_t)DE * D, WD, (size_t)D * DE, nullptr, D, 0, 0);
    k_sp<<<2, 256, 0, stream>>>(lam, vec + V_SP);
    k_tconv4<<<16, 256, 0, stream>>>(rgw, g1, WR);
#endif
#if MK_P1
    mk_launch(a, 1, 2, stream);
#else
    { FProj f{XB, WIN, PROJ, 0, 0}; k_ngemm<<<dim3(NPROJ / 64, T / 64), 256, 0, stream>>>(f); }
#endif
#if MK_P2
    mk_launch(a, 2, 3, stream);
#else
    k_mix_rg<<<NBATCH * 8, 64, 0, stream>>>(PROJ, rg_cw, rg_cb, Wa, ba, Wx, bx, vec + V_SP, Y);
    k_mix_sc<<<(unsigned)(((size_t)T * DRG + 255) / 256), 256, 0, stream>>>(PROJ, sc_cw, Y);
#endif
#if MK_P3
    mk_launch(a, 3, 4, stream);
#else
    { FOut f{Y, WOUT, XB, Z, 0, 0}; k_ngemm<<<dim3(D / 64, T / 64), 256, 0, stream>>>(f); }
    k_pstats<<<T * 16 / 256, 256, 0, stream>>>(Z, PS);
#endif
#if MK_P4
    mk_launch(a, 4, 5, stream);
#else
    k_router<<<T, 64, 0, stream>>>(Z, WR, PS, vec + V_SR, vec + V_TR, cnt, SLOT, TOKSLOT);
#endif
    k_base<<<1, 64, 0, stream>>>(cnt, base);
#if MK_P5
    mk_launch(a, 5, 6, stream);
#else
    { FGateUp f{Z, WGU, SLOT, cnt, base, vec + V_SGU, vec + V_TGU, GU, 0, 0, 0, 0}; k_ngemm<<<dim3(512 / 64, T / 64, NE), 256, 0, stream>>>(f); }
    k_hid<<<dim3(1, T, NE), 256, 0, stream>>>(GU, SLOT, cnt, base, HID);
#endif
#if MK_P6
    mk_launch(a, 6, 7, stream);
#else
    { FDown f{HID, WD, cnt, base, CONTRIB, 0, 0, 0, 0}; k_ngemm<<<dim3(D / 64, T / 64, NE), 256, 0, stream>>>(f); }
#endif
#if MK_P7
    mk_launch(a, 7, 8, stream);
#else
    k_final<<<T, 64, 0, stream>>>(Z, PS, TOKSLOT, base, CONTRIB, g1, b1, g2, b2, (float*)d_out);
#endif
}
```
